# Optimizing an MI355X kernel written in HIP

```python
import jax, jax.numpy as jnp
from jax import lax
import numpy as np

D_MODEL = 1024
BATCH = 2
SEQ = 8192
DEPTH = 1

LRU_WIDTH = D_MODEL
LRU_BLOCKS = 16
LRU_BLOCK_W = LRU_WIDTH // LRU_BLOCKS
LRU_C = 8.0
CONV_W = 4
ATT_HEADS = 16
ATT_HEAD_DIM = 64
ATT_WIDTH = ATT_HEADS * ATT_HEAD_DIM
Q_BLOCK = 128
D_FF = 4 * D_MODEL
PLE_DIM = 256
NORM_EPS = 1e-6

IN_SPLITS = [LRU_WIDTH, LRU_WIDTH, ATT_WIDTH, ATT_WIDTH, ATT_WIDTH, D_MODEL, D_MODEL]
IN_WIDTH = sum(IN_SPLITS)

kernel_name = 'hawk_stickbreak_hybrid'


def rmsnorm(x, g):
    x32 = x.astype(jnp.float32)
    y = x32 * lax.rsqrt(jnp.mean(x32 * x32, axis=-1, keepdims=True) + NORM_EPS)
    return (y * g.astype(jnp.float32)).astype(x.dtype)


def causal_depthwise_conv(x, w, b):
    S = x.shape[1]
    xp = jnp.pad(x, ((0, 0), (CONV_W - 1, 0), (0, 0)))
    y = b
    for k in range(CONV_W):
        y = y + w[k] * xp[:, k:k + S]
    return y


def rg_lru(x, w_r, b_r, w_i, b_i, lam):
    B, S, W = x.shape
    xb = x.reshape(B, S, LRU_BLOCKS, LRU_BLOCK_W)
    r = jax.nn.sigmoid((jnp.einsum('bsnc,ncd->bsnd', xb, w_r).reshape(B, S, W) + b_r).astype(jnp.float32))
    i = jax.nn.sigmoid((jnp.einsum('bsnc,ncd->bsnd', xb, w_i).reshape(B, S, W) + b_i).astype(jnp.float32))
    log_a = -LRU_C * r * jax.nn.softplus(-lam.astype(jnp.float32))
    a = jnp.exp(log_a)
    mult = jnp.sqrt(-jnp.expm1(2.0 * log_a))
    u = mult * (i * x.astype(jnp.float32))

    def combine(left, right):
        a_l, u_l = left
        a_r, u_r = right
        return a_l * a_r, a_r * u_l + u_r

    _, h = lax.associative_scan(combine, (a, u), axis=1)
    return h.astype(x.dtype)


def stick_breaking_attention(q, k, v):
    B, H, S, Dh = q.shape
    n_blk = S // Q_BLOCK
    scale = Dh ** -0.5
    q_blocks = q.reshape(B, H, n_blk, Q_BLOCK, Dh).transpose(2, 0, 1, 3, 4)
    key_pos = jnp.arange(S)

    def one_block(args):
        q_blk, blk = args
        z = jnp.einsum('bhqd,bhkd->bhqk', q_blk, k).astype(jnp.float32) * scale
        q_pos = blk * Q_BLOCK + jnp.arange(Q_BLOCK)
        causal = key_pos[None, :] < q_pos[:, None]
        log_1m = jnp.where(causal, jax.nn.log_sigmoid(-z), 0.0)
        suffix = lax.cumsum(log_1m, axis=3, reverse=True) - log_1m
        att = jnp.where(causal, jnp.exp(jax.nn.log_sigmoid(z) + suffix), 0.0)
        return jnp.einsum('bhqk,bhkd->bhqd', att.astype(v.dtype), v)

    out = lax.map(one_block, (q_blocks, jnp.arange(n_blk)))
    return out.transpose(1, 2, 0, 3, 4).reshape(B, H, S, Dh)


def setup_inputs(seed: int = 0) -> dict:
    key = jax.random.key(seed)
    ks = jax.random.split(key, 24)
    f32 = jnp.float32

    def nrm(k, shape, fan_in):
        return jax.random.normal(k, shape, f32) * (fan_in ** -0.5)

    def gain(k, shape):
        return 1.0 + 0.02 * jax.random.normal(k, shape, f32)

    u = jax.random.uniform(ks[10], (DEPTH, LRU_WIDTH), f32, 0.9, 0.999)
    a0 = u ** (1.0 / LRU_C)
    lam = jnp.log(a0) - jnp.log1p(-a0)
    return {
        'x': jax.random.normal(ks[0], (BATCH, SEQ, D_MODEL), f32),
        'p': jax.random.normal(ks[1], (DEPTH, BATCH, SEQ, PLE_DIM), f32),
        'norm_mix_g': gain(ks[2], (DEPTH, D_MODEL)),
        'w_in': nrm(ks[3], (DEPTH, D_MODEL, IN_WIDTH), D_MODEL),
        'conv_w': nrm(ks[4], (DEPTH, CONV_W, LRU_WIDTH), CONV_W),
        'conv_b': 0.02 * jax.random.normal(ks[5], (DEPTH, LRU_WIDTH), f32),
        'w_rgate': nrm(ks[6], (DEPTH, LRU_BLOCKS, LRU_BLOCK_W, LRU_BLOCK_W), LRU_BLOCK_W),
        'b_rgate': 0.02 * jax.random.normal(ks[7], (DEPTH, LRU_WIDTH), f32),
        'w_igate': nrm(ks[8], (DEPTH, LRU_BLOCKS, LRU_BLOCK_W, LRU_BLOCK_W), LRU_BLOCK_W),
        'b_igate': 0.02 * jax.random.normal(ks[9], (DEPTH, LRU_WIDTH), f32),
        'lru_lambda': lam,
        'w_br_lru': nrm(ks[11], (DEPTH, LRU_WIDTH, D_MODEL), LRU_WIDTH),
        'w_br_att': nrm(ks[12], (DEPTH, ATT_WIDTH, D_MODEL), ATT_WIDTH),
        'w_out': nrm(ks[13], (DEPTH, D_MODEL, D_MODEL), D_MODEL),
        'norm_mlp_g': gain(ks[14], (DEPTH, D_MODEL)),
        'w_mlp_up': nrm(ks[15], (DEPTH, D_MODEL, D_FF), D_MODEL),
        'w_mlp_down': nrm(ks[16], (DEPTH, D_FF, D_MODEL), D_FF),
        'norm_ple_g': gain(ks[17], (DEPTH, D_MODEL)),
        'w_ple_gate': nrm(ks[18], (DEPTH, D_MODEL, D_MODEL), D_MODEL),
        'w_ple': nrm(ks[19], (DEPTH, PLE_DIM, D_MODEL), PLE_DIM),
        'norm_final_g': gain(ks[20], (D_MODEL,)),
    }


def reference(x, p, norm_mix_g, w_in, conv_w, conv_b, w_rgate, b_rgate, w_igate, b_igate,
              lru_lambda, w_br_lru, w_br_att, w_out, norm_mlp_g, w_mlp_up, w_mlp_down,
              norm_ple_g, w_ple_gate, w_ple, norm_final_g):
    B, S, _ = x.shape
    split_idx = [int(s) for s in np.cumsum(IN_SPLITS)[:-1]]
    for l in range(DEPTH):
        h = rmsnorm(x, norm_mix_g[l])
        proj = h @ w_in[l]
        u_x, u_g, q, k, v, g_lru, g_att = jnp.split(proj, split_idx, axis=-1)

        c = causal_depthwise_conv(u_x, conv_w[l], conv_b[l])
        y_lru = rg_lru(c, w_rgate[l], b_rgate[l], w_igate[l], b_igate[l], lru_lambda[l]) * jax.nn.gelu(u_g)

        to_heads = lambda t: t.reshape(B, S, ATT_HEADS, ATT_HEAD_DIM).transpose(0, 2, 1, 3)
        y_att = stick_breaking_attention(to_heads(q), to_heads(k), to_heads(v))
        y_att = y_att.transpose(0, 2, 1, 3).reshape(B, S, ATT_WIDTH)

        merged = jax.nn.sigmoid(g_lru) * (y_lru @ w_br_lru[l]) + jax.nn.sigmoid(g_att) * (y_att @ w_br_att[l])
        x = x + merged @ w_out[l]

        h2 = rmsnorm(x, norm_mlp_g[l])
        x = x + jnp.square(jax.nn.relu(h2 @ w_mlp_up[l])) @ w_mlp_down[l]

        h3 = rmsnorm(x, norm_ple_g[l])
        x = x + jax.nn.sigmoid(h3 @ w_ple_gate[l]) * (p[l] @ w_ple[l])
    return rmsnorm(x, norm_final_g)
```

```cpp
#include <hip/hip_runtime.h>
#include <hip/hip_cooperative_groups.h>
#include <cstdio>
#include <cstdint>
namespace cg = cooperative_groups;

#ifndef MK_PER_PHASE
#define MK_PER_PHASE 0
#endif

namespace pg8 {
#define PG8_LAS __attribute__((address_space(3)))
typedef unsigned short bf16_t;
typedef short bf16x8 __attribute__((ext_vector_type(8)));
typedef float f32x4 __attribute__((ext_vector_type(4)));
typedef unsigned u32x4 __attribute__((ext_vector_type(4)));
constexpr int BM = 256, BK = 64, HALF = 128, HTB = HALF * BK * 2  , STAGE_BYTES = 8 * HTB, NXCD = 8, WGM = 4;

__host__ __device__ __forceinline__ int lds_byte(int r, int c) { const int st = (r >> 4) * 2 + (c >> 5), rr = r & 15, cc = c & 31, ob = rr * 64 + cc * 2; return st * 1024 + (ob ^ (((ob >> 9) & 1) << 5)); }
__host__ __device__ __forceinline__ void stage_rc(int b, int& R, int& C) { const int st = b / 1024, sb = b % 1024, swz = sb ^ (((sb >> 9) & 1) << 5); R = (st >> 1) * 16 + swz / 64; C = (st & 1) * 32 + (swz % 64) / 2; }
__host__ __device__ __forceinline__ int perm32(int rho) { const int n = rho >> 4, i = rho & 15; return 8 * (i >> 2) + 4 * n + (i & 3); }

struct Unit { const char* A; const char* B; int pm, pn, kind; };

__device__ __forceinline__ void swz_tile(int wgid, int nM, int nN, int& pm, int& pn) {
    const int nwg = nM * nN;
    { const int q = nwg / NXCD, r = nwg % NXCD, xcd = wgid % NXCD, off = wgid / NXCD; wgid = (xcd < r ? xcd * (q + 1) : r * (q + 1) + (xcd - r) * q) + off; }
    const int nig = WGM * nN, gid = wgid / nig, fm = gid * WGM, gsz = (nM - fm) < WGM ? (nM - fm) : WGM;
    pm = fm + ((wgid % nig) % gsz); pn = (wgid % nig) / gsz;
}
struct Sched2 {
    const char *A0, *B0, *A1, *B1; int nM0, nN0, nM1, nN1, mode, G, c; size_t tstep;
    __device__ __forceinline__ bool next(int i, Unit& u) const {
        int pm, pn;
        if (mode == 0) {
            const int L = i * G + c, n0 = nM0 * nN0;
            if (L < n0) { swz_tile(L, nM0, nN0, pm, pn); u.pm = pm; u.pn = pn; u.kind = 0; u.A = A0 + (size_t)pm * tstep; u.B = B0 + (size_t)pn * tstep; return true; }
            const int L1 = L - n0; if (L1 >= nM1 * nN1) return false;
            swz_tile(L1, nM1, nN1, pm, pn); u.pm = pm; u.pn = pn; u.kind = 1; u.A = A1 + (size_t)pm * tstep; u.B = B1 + (size_t)pn * tstep; return true;
        } else {
            const int T = (i >> 1) * G + c; if (T >= nM0 * nN0) return false;
            swz_tile(T, nM0, nN0, pm, pn); u.pm = pm; u.pn = pn; u.kind = i & 1;
            u.A = ((i & 1) ? A1 : A0) + (size_t)pm * tstep; u.B = ((i & 1) ? B1 : B0) + (size_t)pn * tstep; return true;
        }
    }
};

template <class Epi, class Sched, bool ALIGN_EPI = false, bool SP2 = false>
__device__ __forceinline__ void gemm_phase(PG8_LAS unsigned char* lds, const int K, const Sched& S, const Epi& E) {
    int tid_ = threadIdx.x; asm volatile("" : "+v"(tid_));
    const int tid = tid_, wid = __builtin_amdgcn_readfirstlane(tid >> 6), lane = tid & 63, wr = wid >> 2, wc = wid & 3, fr = lane & 15, fq = lane >> 4;
    const int nt = K / BK;
    unsigned voffA[2], voffB[2];
#pragma unroll
    for (int i = 0; i < 2; ++i) { int R, C; stage_rc(tid * 16 + i * 8192, R, C); const int Rb = Epi::PERM ? ((R & ~31) + perm32(R & 31)) : R;
        voffA[i] = (unsigned)(R * K + C) * 2u; voffB[i] = (unsigned)(Rb * K + C) * 2u; }
    const size_t kstep = (size_t)(BK * 2);
    const size_t hstep = (size_t)HALF * K * 2;
    const unsigned ldsw = (unsigned)wid * 1024u;
    const int aoff = lds_byte(wr * 64 + fr, fq * 8), boff = lds_byte(wc * 32 + fr, fq * 8);
#define PG8_SA(b, h) (((b) * 2 + (h)) * HTB)
#define PG8_SB(b, h) ((4 + (b) * 2 + (h)) * HTB)
#define PG8_STAGE(bufoff, gbase, voff) do { _Pragma("unroll") for (int _i = 0; _i < 2; ++_i) \
        __builtin_amdgcn_global_load_lds((const unsigned*)((const char*)(gbase) + (voff)[_i]), (PG8_LAS unsigned*)(lds + (bufoff) + ldsw + _i * 8192), 16, 0, 0); } while (0)
#define PG8_LDA(dst, b, h) do { _Pragma("unroll") for (int m = 0; m < 4; ++m) _Pragma("unroll") for (int k = 0; k < 2; ++k) dst[m][k] = *(const PG8_LAS bf16x8*)(lds + PG8_SA(b, h) + aoff + m * 2048 + k * 1024); } while (0)
#define PG8_LDB(dst, b, h) do { _Pragma("unroll") for (int n = 0; n < 2; ++n) _Pragma("unroll") for (int k = 0; k < 2; ++k) dst[n][k] = *(const PG8_LAS bf16x8*)(lds + PG8_SB(b, h) + boff + n * 2048 + k * 1024); } while (0)
#define PG8_MMA(ai, bj, At, Bt) do { __builtin_amdgcn_s_setprio(1); _Pragma("unroll") for (int m = 0; m < 4; ++m) _Pragma("unroll") for (int n = 0; n < 2; ++n) _Pragma("unroll") for (int k = 0; k < 2; ++k) \
        acc[ai][bj][m][n] = __builtin_amdgcn_mfma_f32_16x16x32_bf16(Bt[n][k], At[m][k], acc[ai][bj][m][n], 0, 0, 0); __builtin_amdgcn_s_setprio(0); } while (0)
#define PG8_WAIT_V(n) asm volatile("s_waitcnt vmcnt(" #n ")" ::: "memory")
#define PG8_WAIT_L(n) asm volatile("s_waitcnt lgkmcnt(" #n ")" ::: "memory")
#define PG8_BAR __builtin_amdgcn_s_barrier()
#define PG8_SCHED __builtin_amdgcn_sched_barrier(0)
    Unit cur, nxt; int ui = 0;
    if (!S.next(0, cur)) return;
    f32x4 acc[2][2][4][2];
#pragma unroll
    for (int a = 0; a < 2; ++a)
#pragma unroll
        for (int b = 0; b < 2; ++b)
#pragma unroll
            for (int m = 0; m < 4; ++m)
#pragma unroll
                for (int n = 0; n < 2; ++n) acc[a][b][m][n] = (f32x4){0.f, 0.f, 0.f, 0.f};
    bf16x8 At[4][2], B0[2][2], B1[2][2];
    const char* cA = cur.A; const char* cB = cur.B;
    if constexpr (SP2) {
        PG8_STAGE(PG8_SB(0, 0), cB, voffB); PG8_STAGE(PG8_SB(0, 1), cB + hstep, voffB); PG8_STAGE(PG8_SA(0, 0), cA, voffA); PG8_STAGE(PG8_SA(0, 1), cA + hstep, voffA);
        if (wr == 1) PG8_BAR;
        PG8_WAIT_V(2); PG8_BAR;
        PG8_STAGE(PG8_SB(1, 0), cB + kstep, voffB); PG8_STAGE(PG8_SA(1, 0), cA + kstep, voffA); PG8_STAGE(PG8_SB(1, 1), cB + hstep + kstep, voffB);
        PG8_WAIT_V(6); PG8_BAR;
    } else {
        PG8_STAGE(PG8_SB(0, 0), cB, voffB); PG8_STAGE(PG8_SA(0, 0), cA, voffA); PG8_STAGE(PG8_SB(0, 1), cB + hstep, voffB); PG8_STAGE(PG8_SA(0, 1), cA + hstep, voffA);
        if (wr == 1) PG8_BAR;
        PG8_WAIT_V(4); PG8_BAR;
        PG8_STAGE(PG8_SB(1, 0), cB + kstep, voffB); PG8_STAGE(PG8_SA(1, 0), cA + kstep, voffA); PG8_STAGE(PG8_SB(1, 1), cB + hstep + kstep, voffB);
        PG8_WAIT_V(6); PG8_BAR;
    }
    for (;;) {
        const bool has_next = S.next(ui + 1, nxt);
        const char* nA = has_next ? nxt.A : cA; const char* nB = has_next ? nxt.B : cB;
        for (int t = 0; t < nt; t += 2) {
            const bool last = (t == nt - 2);
            const char* a1 = cA + (size_t)(t + 1) * kstep;
            const char* a2 = last ? nA : cA + (size_t)(t + 2) * kstep; const char* b2 = last ? nB : cB + (size_t)(t + 2) * kstep;
            const char* a3 = a2 + kstep; const char* b3 = b2 + kstep;
            if constexpr (SP2) {
            PG8_LDB(B0, 0, 0); PG8_LDB(B1, 0, 1); PG8_SCHED; PG8_LDA(At, 0, 0); PG8_STAGE(PG8_SA(1, 1), a1 + hstep, voffA);
            PG8_WAIT_V(8); PG8_WAIT_L(0); PG8_BAR; PG8_MMA(0, 0, At, B0); PG8_MMA(0, 1, At, B1); PG8_BAR; PG8_SCHED;
            PG8_LDA(At, 0, 1); PG8_STAGE(PG8_SB(0, 0), b2, voffB); PG8_STAGE(PG8_SB(0, 1), b2 + hstep, voffB); PG8_STAGE(PG8_SA(0, 0), a2, voffA);
            PG8_WAIT_V(8); PG8_WAIT_L(0); PG8_BAR; PG8_MMA(1, 0, At, B0); PG8_MMA(1, 1, At, B1); PG8_BAR; PG8_SCHED;
            PG8_LDB(B0, 1, 0); PG8_LDB(B1, 1, 1); PG8_SCHED; PG8_LDA(At, 1, 0); PG8_STAGE(PG8_SA(0, 1), a2 + hstep, voffA);
            PG8_WAIT_V(8); PG8_WAIT_L(0); PG8_BAR; PG8_MMA(0, 0, At, B0); PG8_MMA(0, 1, At, B1); PG8_BAR; PG8_SCHED;
            PG8_LDA(At, 1, 1); PG8_STAGE(PG8_SB(1, 0), b3, voffB); PG8_STAGE(PG8_SB(1, 1), b3 + hstep, voffB); PG8_STAGE(PG8_SA(1, 0), a3, voffA);
            PG8_WAIT_V(8); PG8_WAIT_L(0); PG8_BAR; PG8_MMA(1, 0, At, B0); PG8_MMA(1, 1, At, B1); PG8_BAR; PG8_SCHED;
            } else {
            PG8_LDB(B0, 0, 0); PG8_SCHED; PG8_LDA(At, 0, 0); PG8_STAGE(PG8_SA(1, 1), a1 + hstep, voffA);
            PG8_WAIT_L(8); PG8_BAR; PG8_WAIT_L(0); PG8_MMA(0, 0, At, B0); PG8_BAR; PG8_SCHED;
            PG8_LDB(B1, 0, 1); PG8_STAGE(PG8_SB(0, 0), b2, voffB);
            PG8_BAR; PG8_WAIT_L(0); PG8_MMA(0, 1, At, B1); PG8_BAR;
            PG8_LDA(At, 0, 1); PG8_STAGE(PG8_SA(0, 0), a2, voffA);
            PG8_BAR; PG8_WAIT_L(0); PG8_MMA(1, 0, At, B0); PG8_BAR; PG8_SCHED;
            PG8_STAGE(PG8_SB(0, 1), b2 + hstep, voffB);
            PG8_WAIT_V(6); PG8_BAR; PG8_MMA(1, 1, At, B1); PG8_BAR;
            PG8_LDB(B0, 1, 0); PG8_SCHED; PG8_LDA(At, 1, 0); PG8_STAGE(PG8_SA(0, 1), a2 + hstep, voffA);
            PG8_WAIT_L(8); PG8_BAR; PG8_WAIT_L(0); PG8_MMA(0, 0, At, B0); PG8_BAR; PG8_SCHED;
            PG8_LDB(B1, 1, 1); PG8_STAGE(PG8_SB(1, 0), b3, voffB);
            PG8_BAR; PG8_WAIT_L(0); PG8_MMA(0, 1, At, B1); PG8_BAR;
            PG8_LDA(At, 1, 1); PG8_STAGE(PG8_SA(1, 0), a3, voffA);
            PG8_BAR; PG8_WAIT_L(0); PG8_MMA(1, 0, At, B0); PG8_BAR; PG8_SCHED;
            PG8_STAGE(PG8_SB(1, 1), b3 + hstep, voffB);
            PG8_WAIT_V(6); PG8_BAR; PG8_MMA(1, 1, At, B1); PG8_BAR;
            }
        }
        if constexpr (ALIGN_EPI) { if (wr == 0) PG8_BAR; }
        { int l2 = lane; asm volatile("" : "+v"(l2)); E(acc, cur, wr, wc, l2 & 15, l2 >> 4); }
        if (!has_next) break;
        if (!E.keep(cur)) {
#pragma unroll
        for (int a = 0; a < 2; ++a)
#pragma unroll
            for (int b = 0; b < 2; ++b)
#pragma unroll
                for (int m = 0; m < 4; ++m)
#pragma unroll
                    for (int n = 0; n < 2; ++n) acc[a][b][m][n] = (f32x4){0.f, 0.f, 0.f, 0.f};
        }
        cur = nxt; cA = nA; cB = nB; ++ui;
        if constexpr (ALIGN_EPI) { if (wr == 1) PG8_BAR; }
    }
    PG8_WAIT_V(0);
    if constexpr (!ALIGN_EPI) { if (wr == 0) PG8_BAR; }
    PG8_BAR;
#undef PG8_SA
#undef PG8_SB
#undef PG8_STAGE
#undef PG8_LDA
#undef PG8_LDB
#undef PG8_MMA
#undef PG8_WAIT_V
#undef PG8_WAIT_L
#undef PG8_BAR
#undef PG8_SCHED
}}

constexpr int NB = 2, SEQ = 8192, DM = 1024, MT = NB * SEQ, NH = 16, HD = 64, FF = 4096, PLE = 256, NIN = 7168, NMAIN = 6144;
constexpr float EPS = 1e-6f, LOG2E = 1.4426950408889634f, LN2 = 0.6931471805599453f;
constexpr int NWAVES = 8, NPHASE = 10;
constexpr int LDS_BYTES = 151552;

constexpr size_t MiB = 1u << 20;
constexpr size_t WS_KMAX = 0, WS_AGG = 1 * MiB, WS_SS1 = 2 * MiB, WS_SS2 = 3 * MiB, WS_SS3 = 4 * MiB, WS_WGF = 5 * MiB, WS_BAR = 6 * MiB, BAR_BYTES = 16384;
constexpr size_t WS_WIN = 8 * MiB, WS_WBRL = 22 * MiB, WS_WBRA = 24 * MiB, WS_WOUT = 26 * MiB, WS_WUP = 28 * MiB, WS_WDN = 36 * MiB, WS_WPG = 44 * MiB, WS_WPLE = 46 * MiB;
constexpr size_t WS_PB = 48 * MiB;
constexpr size_t WS_XN = 56 * MiB;
constexpr size_t WS_UX = 88 * MiB;
constexpr size_t WS_UG = 120 * MiB;
constexpr size_t WS_Q = 152 * MiB;
constexpr size_t WS_K = 184 * MiB;
constexpr size_t WS_VT = 216 * MiB;
constexpr size_t WS_END = 248 * MiB;

#define LAS __attribute__((address_space(3)))
typedef unsigned short bf16_t;
typedef short bf16x8 __attribute__((ext_vector_type(8)));
typedef float f32x4 __attribute__((ext_vector_type(4)));
typedef float f32x16 __attribute__((ext_vector_type(16)));
typedef unsigned u32x4 __attribute__((ext_vector_type(4)));
typedef unsigned u32x2 __attribute__((ext_vector_type(2)));
typedef float f32x2_t __attribute__((ext_vector_type(2)));
typedef __bf16 bf16x2_t __attribute__((ext_vector_type(2)));

__device__ __forceinline__ unsigned cvt_pk(float lo, float hi) { f32x2_t v = {lo, hi}; bf16x2_t b = __builtin_convertvector(v, bf16x2_t); return __builtin_bit_cast(unsigned, b); }
__device__ __forceinline__ float bflo(unsigned w) { return __builtin_bit_cast(float, w << 16); }
__device__ __forceinline__ float bfhi(unsigned w) { return __builtin_bit_cast(float, w & 0xffff0000u); }
__device__ __forceinline__ float fsigmoid(float v) { return __builtin_amdgcn_rcpf(1.f + __builtin_amdgcn_exp2f(-LOG2E * v)); }
__device__ __forceinline__ float gelu_tanh(float v) { const float y = 1.5957691216057308f * (v + 0.044715f * v * v * v); return v * fsigmoid(y); }
__device__ __forceinline__ u32x4 pack8(f32x4 a, f32x4 b) { u32x4 w; w.x = cvt_pk(a[0], a[1]); w.y = cvt_pk(a[2], a[3]); w.z = cvt_pk(b[0], b[1]); w.w = cvt_pk(b[2], b[3]); return w; }
__device__ __forceinline__ float wave_sum(float v) {
#pragma unroll
    for (int o = 1; o < 64; o <<= 1) v += __shfl_xor(v, o);
    return v;
}
__device__ __forceinline__ float row_rstd(const float* ss, int row) {
    const f32x4* p = (const f32x4*)(ss + (size_t)row * 16); const f32x4 a = p[0], b = p[1], c = p[2], d = p[3];
    const float s = (((a[0] + a[1]) + (a[2] + a[3])) + ((b[0] + b[1]) + (b[2] + b[3]))) + (((c[0] + c[1]) + (c[2] + c[3])) + ((d[0] + d[1]) + (d[2] + d[3])));
    return __builtin_amdgcn_rsqf(s * (1.f / DM) + EPS);
}
__device__ __forceinline__ int crow(int r, int hi) { return (r & 3) + 8 * (r >> 2) + 4 * hi; }


#define GAS __attribute__((address_space(1)))
#define RLX_AGENT __ATOMIC_RELAXED, __HIP_MEMORY_SCOPE_AGENT
#define XB_TMO      128
#define XB_XCNT(j)  (256  + 64 * (j))
#define XB_XSUB(j)  (1280 + 64 * (j))
#define XB_XGEN(j)  (2304 + 64 * (j))
#define XB_TOP      3328
#define XB_TOPGEN   3392
#define XCD_BAR_WORDS 3456
#define XB_SPIN_CAP (1u << 18)

__device__ __forceinline__ unsigned xb_ld(unsigned* p)              { return __hip_atomic_load(p, __ATOMIC_RELAXED, __HIP_MEMORY_SCOPE_AGENT); }
__device__ __forceinline__ unsigned xb_add(unsigned* p, unsigned v) { return __hip_atomic_fetch_add(p, v, __ATOMIC_RELAXED, __HIP_MEMORY_SCOPE_AGENT); }
__device__ __forceinline__ unsigned xb_xcc_id() { return (unsigned)__builtin_amdgcn_s_getreg((3 << 11) | 20) & 0xFu; }
#define XB_SPIN(cond, bar) do { unsigned _sp = 0; while (cond) { __builtin_amdgcn_s_sleep(1); \
    if ((++_sp & 255u) == 0u) { if (xb_ld(&(bar)[XB_TMO])) break; if (_sp > XB_SPIN_CAP) { atomicAdd(&(bar)[XB_TMO], 1u); break; } } } } while (0)

struct XcdBarrier {
    unsigned* bar; unsigned x;
    volatile LAS unsigned* st;
};

__device__ __forceinline__ XcdBarrier xcd_barrier_post(unsigned* bar, volatile LAS unsigned* st) {
    XcdBarrier b; b.bar = bar; b.x = xb_xcc_id(); b.st = st;
    if (threadIdx.x == 0) (void)xb_add(&bar[XB_XCNT(b.x)], 1u);
    return b;
}
__device__ __forceinline__ void xcd_barrier_complete(unsigned* bar, unsigned x, unsigned& nloc, unsigned& nx) {
    const unsigned G = gridDim.x * gridDim.y * gridDim.z;
    unsigned sum, cnt, mine, sp = 0u;
    for (;;) {
        sum = 0u; cnt = 0u; mine = 0u;
#pragma unroll
        for (unsigned j = 0; j < 16; ++j) { const unsigned c = xb_ld(&bar[XB_XCNT(j)]); sum += c; cnt += (c > 0u) ? 1u : 0u; mine = (j == x) ? c : mine; }
        if (sum == G) break;
        __builtin_amdgcn_s_sleep(1);
        if ((++sp & 255u) == 0u) { if (xb_ld(&bar[XB_TMO])) break; if (sp > XB_SPIN_CAP) { atomicAdd(&bar[XB_TMO], 1u); break; } }
    }
    nloc = mine > 0u ? mine : 1u; nx = cnt > 0u ? cnt : 1u;
}

__device__ __forceinline__ void xcd_barrier(const XcdBarrier& b) {
    asm volatile("s_waitcnt vmcnt(0)" ::: "memory");
    __syncthreads();
    if (threadIdx.x == 0) {
        unsigned* bar = b.bar;
        __builtin_amdgcn_s_waitcnt(0);
        unsigned nloc = b.st[0], nx = b.st[1];
        if (nloc == 0u) { xcd_barrier_complete(bar, b.x, nloc, nx); b.st[0] = nloc; b.st[1] = nx; }
        const unsigned old = xb_add(&bar[XB_XSUB(b.x)], 1u);
        const unsigned gen = old / nloc;
        if (old + 1u == (gen + 1u) * nloc) {
            __builtin_amdgcn_fence(__ATOMIC_RELEASE, "agent");
            asm volatile("s_waitcnt vmcnt(0)" ::: "memory");
            const unsigned og = xb_add(&bar[XB_TOP], 1u);
            const unsigned tg = og / nx;
            if (og + 1u == (tg + 1u) * nx) xb_add(&bar[XB_TOPGEN], 1u);
            else XB_SPIN(xb_ld(&bar[XB_TOPGEN]) == tg, bar);
            __builtin_amdgcn_fence(__ATOMIC_ACQUIRE, "agent");
            xb_add(&bar[XB_XGEN(b.x)], 1u);
            asm volatile("s_waitcnt vmcnt(0)" ::: "memory");
        } else {
            XB_SPIN(xb_ld(&bar[XB_XGEN(b.x)]) == gen, bar);
            __builtin_amdgcn_fence(__ATOMIC_ACQUIRE, "agent");
            asm volatile("s_waitcnt vmcnt(0)" ::: "memory");
        }
    }
    __syncthreads();
}
#define EPI_ARGS const f32x4 (&acc)[2][2][4][2], const pg8::Unit& u, int wr, int wc, int fr, int fq

struct EpiIn {
    static constexpr bool PERM = true;
    __device__ __forceinline__ bool keep(const pg8::Unit&) const { return false; }
    bf16_t *UX, *UG, *Q, *K, *GL, *GA, *VT;
    __device__ __forceinline__ void operator()(EPI_ARGS) const {
        const int row0 = u.pm * 256 + wr * 64 + fr, colt = u.pn * 256 + wc * 32 + 8 * fq;
        if (u.kind == 1) {
#pragma unroll
            for (int ai = 0; ai < 2; ++ai)
#pragma unroll
                for (int m = 0; m < 4; ++m) { bf16_t* rowp = VT + (size_t)(row0 + ai * 128 + m * 16) * MT + colt;
#pragma unroll
                    for (int bj = 0; bj < 2; ++bj) { const u32x4 w = pack8(acc[ai][bj][m][0], acc[ai][bj][m][1]);
                        bf16_t* g16 = rowp + bj * 128 - (fq & 1) * 8;
                        u32x2 lo2 = {w.x, w.y}, hi2 = {w.z, w.w};
                        *(u32x2*)(g16 + ((fq & 1) ? 4 : 0)) = lo2; *(u32x2*)(g16 + ((fq & 1) ? 12 : 8)) = hi2; } }
            return;
        }
        const int sec = u.pn >> 2, cs = colt - sec * 1024;
        bf16_t* base = sec == 0 ? UX : sec == 1 ? UG : sec == 2 ? Q : sec == 3 ? K : sec == 4 ? GL : GA;
#pragma unroll
        for (int ai = 0; ai < 2; ++ai)
#pragma unroll
            for (int m = 0; m < 4; ++m) { bf16_t* rowp = base + (size_t)(row0 + ai * 128 + m * 16) * DM + cs;
#pragma unroll
                for (int bj = 0; bj < 2; ++bj) { f32x4 v0 = acc[ai][bj][m][0], v1 = acc[ai][bj][m][1];
                    if (sec == 1) {
#pragma unroll
                        for (int e = 0; e < 4; ++e) { v0[e] = gelu_tanh(v0[e]); v1[e] = gelu_tanh(v1[e]); }
                    } else if (sec == 2) { v0 = v0 * 0.125f; v1 = v1 * 0.125f; }
                    else if (sec >= 4) {
#pragma unroll
                        for (int e = 0; e < 4; ++e) { v0[e] = fsigmoid(v0[e]); v1[e] = fsigmoid(v1[e]); }
                    }
                    const u32x4 w = pack8(v0, v1);
                    *(u32x4*)(rowp + bj * 128) = w;
} }
    }
};

struct EpiBr {
    static constexpr bool PERM = true;
    bf16_t* MG; const bf16_t* GL; const bf16_t* GA;
    __device__ __forceinline__ bool keep(const pg8::Unit& u) const { return u.kind == 0; }
    __device__ __forceinline__ void operator()(f32x4 (&acc)[2][2][4][2], const pg8::Unit& u, int wr, int wc, int fr, int fq) const {
        const int row0 = u.pm * 256 + wr * 64 + fr, colt = u.pn * 256 + wc * 32 + 8 * fq;
#pragma unroll
        for (int ai = 0; ai < 2; ++ai) {
            u32x4 gav[4][2], glv[4][2];
#pragma unroll
            for (int m = 0; m < 4; ++m)
#pragma unroll
                for (int bj = 0; bj < 2; ++bj) { const size_t o = (size_t)(row0 + ai * 128 + m * 16) * DM + colt + bj * 128;
                    gav[m][bj] = *(const u32x4*)(GA + o); glv[m][bj] = u.kind == 0 ? *(const u32x4*)(GL + o) : gav[m][bj]; }
            __builtin_amdgcn_sched_barrier(0);
#pragma unroll
            for (int m = 0; m < 4; ++m)
#pragma unroll
                for (int bj = 0; bj < 2; ++bj) { const size_t o = (size_t)(row0 + ai * 128 + m * 16) * DM + colt + bj * 128;
                    const u32x4 ga = gav[m][bj];
                    float a8[8] = {bflo(ga.x), bfhi(ga.x), bflo(ga.y), bfhi(ga.y), bflo(ga.z), bfhi(ga.z), bflo(ga.w), bfhi(ga.w)};
#pragma unroll
                    for (int e = 0; e < 8; ++e) a8[e] = fmaxf(a8[e], 1e-30f);
                    if (u.kind == 0) { const u32x4 gl = glv[m][bj];
                        const float l8[8] = {bflo(gl.x), bfhi(gl.x), bflo(gl.y), bfhi(gl.y), bflo(gl.z), bfhi(gl.z), bflo(gl.w), bfhi(gl.w)};
#pragma unroll
                        for (int e = 0; e < 4; ++e) { acc[ai][bj][m][0][e] *= l8[e] * __builtin_amdgcn_rcpf(a8[e]); acc[ai][bj][m][1][e] *= l8[4 + e] * __builtin_amdgcn_rcpf(a8[4 + e]); }
                    } else { f32x4 v0 = acc[ai][bj][m][0], v1 = acc[ai][bj][m][1];
#pragma unroll
                        for (int e = 0; e < 4; ++e) { v0[e] *= a8[e]; v1[e] *= a8[4 + e]; }
                        *(u32x4*)(MG + o) = pack8(v0, v1); } }
            __builtin_amdgcn_sched_barrier(0); }
    }
};

template <bool IN_BF16>
struct EpiRes {
    static constexpr bool PERM = true;
    __device__ __forceinline__ bool keep(const pg8::Unit&) const { return false; }
    const void* xin; bf16_t* xb; float* ss;
    __device__ __forceinline__ void operator()(EPI_ARGS) const {
        const int row0 = u.pm * 256 + wr * 64 + fr, colt = u.pn * 256 + wc * 32 + 8 * fq;
#pragma unroll
        for (int ai = 0; ai < 2; ++ai) {
            f32x4 xa[4][2], xc[4][2]; u32x4 xt[4][2];
#pragma unroll
            for (int m = 0; m < 4; ++m)
#pragma unroll
                for (int bj = 0; bj < 2; ++bj) { const size_t o = (size_t)(row0 + ai * 128 + m * 16) * DM + colt + bj * 128;
                    if (IN_BF16) xt[m][bj] = *(const u32x4*)((const bf16_t*)xin + o);
                    else { xa[m][bj] = *(const f32x4*)((const float*)xin + o); xc[m][bj] = *(const f32x4*)((const float*)xin + o + 4); } }
            __builtin_amdgcn_sched_barrier(0);
#pragma unroll
            for (int m = 0; m < 4; ++m) { const int row = row0 + ai * 128 + m * 16; const size_t ro = (size_t)row * DM + colt; float s = 0.f;
#pragma unroll
                for (int bj = 0; bj < 2; ++bj) { const size_t o = ro + bj * 128;
                    f32x4 v0 = acc[ai][bj][m][0], v1 = acc[ai][bj][m][1];
                    if (IN_BF16) { const u32x4 t = xt[m][bj];
                        v0[0] += bflo(t.x); v0[1] += bfhi(t.x); v0[2] += bflo(t.y); v0[3] += bfhi(t.y); v1[0] += bflo(t.z); v1[1] += bfhi(t.z); v1[2] += bflo(t.w); v1[3] += bfhi(t.w);
                    } else { v0 = v0 + xa[m][bj]; v1 = v1 + xc[m][bj]; }
                    *(u32x4*)(xb + o) = pack8(v0, v1);
                    s += ((v0[0] * v0[0] + v0[1] * v0[1]) + (v0[2] * v0[2] + v0[3] * v0[3])) + ((v1[0] * v1[0] + v1[1] * v1[1]) + (v1[2] * v1[2] + v1[3] * v1[3])); }
                s += __shfl_xor(s, 16); s += __shfl_xor(s, 32);
                if (fq == 0) ss[(size_t)row * 16 + u.pn * 4 + wc] = s; }
            __builtin_amdgcn_sched_barrier(0); }
    }
};

struct EpiUp {
    static constexpr bool PERM = true;
    __device__ __forceinline__ bool keep(const pg8::Unit&) const { return false; }
    bf16_t* H; const float* ss;
    __device__ __forceinline__ void operator()(EPI_ARGS) const {
        const int row0 = u.pm * 256 + wr * 64 + fr, colt = u.pn * 256 + wc * 32 + 8 * fq;
#pragma unroll
        for (int ai = 0; ai < 2; ++ai) {
            float rsv[4];
#pragma unroll
            for (int m = 0; m < 4; ++m) rsv[m] = row_rstd(ss, row0 + ai * 128 + m * 16);
            __builtin_amdgcn_sched_barrier(0);
#pragma unroll
            for (int m = 0; m < 4; ++m) { const int row = row0 + ai * 128 + m * 16; const float rs = rsv[m]; bf16_t* rowp = H + (size_t)row * FF + colt;
#pragma unroll
                for (int bj = 0; bj < 2; ++bj) { f32x4 v0 = acc[ai][bj][m][0] * rs, v1 = acc[ai][bj][m][1] * rs;
#pragma unroll
                    for (int e = 0; e < 4; ++e) { const float a = fmaxf(v0[e], 0.f), b = fmaxf(v1[e], 0.f); v0[e] = a * a; v1[e] = b * b; }
                    *(u32x4*)(rowp + bj * 128) = pack8(v0, v1); } }
            __builtin_amdgcn_sched_barrier(0); }
    }
};

struct EpiE {
    static constexpr bool PERM = true;
    __device__ __forceinline__ bool keep(const pg8::Unit&) const { return false; }
    bf16_t* E;
    __device__ __forceinline__ void operator()(EPI_ARGS) const {
        const int row0 = u.pm * 256 + wr * 64 + fr, colt = u.pn * 256 + wc * 32 + 8 * fq;
#pragma unroll
        for (int ai = 0; ai < 2; ++ai)
#pragma unroll
            for (int m = 0; m < 4; ++m) { bf16_t* rowp = E + (size_t)(row0 + ai * 128 + m * 16) * DM + colt;
#pragma unroll
                for (int bj = 0; bj < 2; ++bj) *(u32x4*)(rowp + bj * 128) = pack8(acc[ai][bj][m][0], acc[ai][bj][m][1]); }
    }
};

struct EpiPle {
    static constexpr bool PERM = true;
    __device__ __forceinline__ bool keep(const pg8::Unit&) const { return false; }
    const bf16_t* x2; bf16_t* E; const float* ss_in; float* ss_out;
    __device__ __forceinline__ void operator()(EPI_ARGS) const {
        const int row0 = u.pm * 256 + wr * 64 + fr, colt = u.pn * 256 + wc * 32 + 8 * fq;
#pragma unroll
        for (int ai = 0; ai < 2; ++ai)
#pragma unroll
        for (int mh = 0; mh < 2; ++mh) {
            float rsv[2]; u32x4 evv[2][2], xvv[2][2];
#pragma unroll
            for (int mm = 0; mm < 2; ++mm) { const int m = 2 * mh + mm; rsv[mm] = row_rstd(ss_in, row0 + ai * 128 + m * 16);
#pragma unroll
                for (int bj = 0; bj < 2; ++bj) { const size_t o = (size_t)(row0 + ai * 128 + m * 16) * DM + colt + bj * 128; evv[mm][bj] = *(const u32x4*)(E + o); xvv[mm][bj] = *(const u32x4*)(x2 + o); } }
            __builtin_amdgcn_sched_barrier(0);
#pragma unroll
            for (int mm = 0; mm < 2; ++mm) { const int m = 2 * mh + mm; const int row = row0 + ai * 128 + m * 16; const float rs = rsv[mm]; const size_t ro = (size_t)row * DM + colt; float s = 0.f;
#pragma unroll
                for (int bj = 0; bj < 2; ++bj) { const size_t o = ro + bj * 128;
                    const u32x4 ev = evv[mm][bj], xv = xvv[mm][bj];
                    f32x4 g0 = acc[ai][bj][m][0] * rs, g1 = acc[ai][bj][m][1] * rs;
#pragma unroll
                    for (int e = 0; e < 4; ++e) { g0[e] = fsigmoid(g0[e]); g1[e] = fsigmoid(g1[e]); }
                    f32x4 v0, v1;
                    v0[0] = bflo(xv.x) + g0[0] * bflo(ev.x); v0[1] = bfhi(xv.x) + g0[1] * bfhi(ev.x); v0[2] = bflo(xv.y) + g0[2] * bflo(ev.y); v0[3] = bfhi(xv.y) + g0[3] * bfhi(ev.y);
                    v1[0] = bflo(xv.z) + g1[0] * bflo(ev.z); v1[1] = bfhi(xv.z) + g1[1] * bfhi(ev.z); v1[2] = bflo(xv.w) + g1[2] * bflo(ev.w); v1[3] = bfhi(xv.w) + g1[3] * bfhi(ev.w);
                    *(u32x4*)(E + o) = pack8(v0, v1);
                    s += ((v0[0] * v0[0] + v0[1] * v0[1]) + (v0[2] * v0[2] + v0[3] * v0[3])) + ((v1[0] * v1[0] + v1[1] * v1[1]) + (v1[2] * v1[2] + v1[3] * v1[3])); }
                s += __shfl_xor(s, 16); s += __shfl_xor(s, 32);
                if (fq == 0) ss_out[(size_t)row * 16 + u.pn * 4 + wc] = s; }
            __builtin_amdgcn_sched_barrier(0); }
    }
};

__device__ __forceinline__ void p0_transpose_item(const float* W, int K, int N, bf16_t* WT, int k0, int n0, int drow0, const float* gs, LAS float* scr, int lane) {
    float wv[32];
#pragma unroll
    for (int i = 0; i < 32; ++i) wv[i] = W[(size_t)(k0 + 2 * i + (lane >> 5)) * N + n0 + (lane & 31)];
    if (gs) {
#pragma unroll
        for (int i = 0; i < 32; ++i) wv[i] *= gs[k0 + 2 * i + (lane >> 5)]; }
#pragma unroll
    for (int i = 0; i < 32; ++i) scr[(2 * i + (lane >> 5)) * 33 + (lane & 31)] = wv[i];
    asm volatile("s_waitcnt lgkmcnt(0)" ::: "memory");
    const int c = lane & 7;
#pragma unroll
    for (int j = 0; j < 4; ++j) { const int n = (lane >> 3) + 8 * j; const LAS float* s = scr + (8 * c) * 33 + n;
        u32x4 o; o.x = cvt_pk(s[0 * 33], s[1 * 33]); o.y = cvt_pk(s[2 * 33], s[3 * 33]); o.z = cvt_pk(s[4 * 33], s[5 * 33]); o.w = cvt_pk(s[6 * 33], s[7 * 33]);
        *(u32x4*)(WT + (size_t)(drow0 + n) * K + k0 + 8 * c) = o; }
    asm volatile("s_waitcnt lgkmcnt(0)" ::: "memory");
}

struct Ptrs {
    const float *x, *p, *g_mix, *w_in, *conv_w, *conv_b, *w_rg, *b_rg, *w_ig, *b_ig, *lam, *w_brl, *w_bra, *w_out, *g_mlp, *w_up, *w_dn, *g_ple, *w_pg, *w_ple, *g_fin;
    float* out; unsigned char* ws;
};

template <int PART>
__device__ __forceinline__ void phase0(const Ptrs& P, LAS float* scr, int gw, int NGW, int lane) {
    unsigned char* ws = P.ws;
    constexpr int I_IN = (DM / 64) * (NIN / 32), I_SQ = (DM / 64) * (DM / 32), I_UP = (DM / 64) * (FF / 32), I_DN = (FF / 64) * (DM / 32), I_PLE = (PLE / 64) * (DM / 32);
    constexpr int NITEMS = PART == 0 ? I_IN : 4 * I_SQ + I_UP + I_DN + I_PLE;
    for (int it = gw; it < NITEMS; it += NGW) {
        int r = PART == 0 ? it : it + I_IN;
        if (r < I_IN) { const int nblk = NIN / 32, kb = r / nblk, nb = r % nblk, n0 = 32 * nb, sec = n0 >> 10;
            const int d0 = sec < 4 ? n0 : (sec == 4 ? NMAIN + (n0 - 4096) : n0 - 1024);
            p0_transpose_item(P.w_in, DM, NIN, (bf16_t*)(ws + WS_WIN), 64 * kb, n0, d0 - n0 + n0, nullptr, scr, lane); continue; } r -= I_IN;
        if (r < I_SQ) { const int nblk = DM / 32; p0_transpose_item(P.w_brl, DM, DM, (bf16_t*)(ws + WS_WBRL), 64 * (r / nblk), 32 * (r % nblk), 32 * (r % nblk), nullptr, scr, lane); continue; } r -= I_SQ;
        if (r < I_SQ) { const int nblk = DM / 32; p0_transpose_item(P.w_bra, DM, DM, (bf16_t*)(ws + WS_WBRA), 64 * (r / nblk), 32 * (r % nblk), 32 * (r % nblk), nullptr, scr, lane); continue; } r -= I_SQ;
        if (r < I_SQ) { const int nblk = DM / 32; p0_transpose_item(P.w_out, DM, DM, (bf16_t*)(ws + WS_WOUT), 64 * (r / nblk), 32 * (r % nblk), 32 * (r % nblk), nullptr, scr, lane); continue; } r -= I_SQ;
        if (r < I_SQ) { const int nblk = DM / 32; p0_transpose_item(P.w_pg, DM, DM, (bf16_t*)(ws + WS_WPG), 64 * (r / nblk), 32 * (r % nblk), 32 * (r % nblk), P.g_ple, scr, lane); continue; } r -= I_SQ;
        if (r < I_UP) { const int nblk = FF / 32; p0_transpose_item(P.w_up, DM, FF, (bf16_t*)(ws + WS_WUP), 64 * (r / nblk), 32 * (r % nblk), 32 * (r % nblk), P.g_mlp, scr, lane); continue; } r -= I_UP;
        if (r < I_DN) { const int nblk = DM / 32; p0_transpose_item(P.w_dn, FF, DM, (bf16_t*)(ws + WS_WDN), 64 * (r / nblk), 32 * (r % nblk), 32 * (r % nblk), nullptr, scr, lane); continue; } r -= I_DN;
        { const int nblk = DM / 32; p0_transpose_item(P.w_ple, PLE, DM, (bf16_t*)(ws + WS_WPLE), 64 * (r / nblk), 32 * (r % nblk), 32 * (r % nblk), nullptr, scr, lane); }
    }
    bf16_t* XN = (bf16_t*)(ws + WS_XN);
    if (PART == 0)
    for (int m = gw; m < MT; m += NGW) {
        const f32x4* xr = (const f32x4*)(P.x + (size_t)m * DM) + lane; const f32x4* gr = (const f32x4*)P.g_mix + lane;
        f32x4 v[4]; float s = 0.f;
#pragma unroll
        for (int j = 0; j < 4; ++j) { v[j] = xr[64 * j]; s += (v[j][0] * v[j][0] + v[j][1] * v[j][1]) + (v[j][2] * v[j][2] + v[j][3] * v[j][3]); }
        const float rstd = __builtin_amdgcn_rsqf(wave_sum(s) * (1.f / DM) + EPS);
        u32x2* o8 = (u32x2*)(XN + (size_t)m * DM) + lane;
#pragma unroll
        for (int j = 0; j < 4; ++j) { const f32x4 g = gr[64 * j]; u32x2 o; o.x = cvt_pk(v[j][0] * rstd * g[0], v[j][1] * rstd * g[1]); o.y = cvt_pk(v[j][2] * rstd * g[2], v[j][3] * rstd * g[3]); o8[64 * j] = o; }
    }
    if (PART == 1) { bf16_t* PB = (bf16_t*)(ws + WS_PB); const int ngrp = MT * PLE / 8;
#pragma unroll 4
        for (int gidx = gw * 64 + lane; gidx < ngrp; gidx += NGW * 64) { const f32x4 a = *(const f32x4*)(P.p + (size_t)gidx * 8), b = *(const f32x4*)(P.p + (size_t)gidx * 8 + 4); *(u32x4*)(PB + (size_t)gidx * 8) = pack8(a, b); } }
    if (PART == 0) { bf16_t* WGF = (bf16_t*)(ws + WS_WGF);
        for (int f = gw; f < 256; f += NGW) { const int kk = f & 3, cbh = (f >> 2) & 1, gate = (f >> 3) & 1, n = f >> 4;
            const float* w = (gate ? P.w_ig : P.w_rg) + (size_t)n * 4096 + (size_t)(16 * kk + 8 * (lane >> 5)) * 64 + 32 * cbh + (lane & 31);
            u32x4 o; o.x = cvt_pk(w[0], w[64]); o.y = cvt_pk(w[128], w[192]); o.z = cvt_pk(w[256], w[320]); o.w = cvt_pk(w[384], w[448]);
            *(u32x4*)(WGF + ((size_t)f * 64 + lane) * 8) = o; } }
}

template <bool PASS_B>
__device__ __forceinline__ void lru_unit(const Ptrs& P, LAS unsigned char* wlds  , int wu, int lane) {
    unsigned char* ws = P.ws;
    const bf16_t* UX = (const bf16_t*)(ws + WS_UX); bf16_t* UG = (bf16_t*)(ws + WS_UG); bf16_t* YL = (bf16_t*)(ws + WS_XN);
    float* AGG = (float*)(ws + WS_AGG); const bf16_t* WGF = (const bf16_t*)(ws + WS_WGF);
    const int n = wu & 15, chunk = (wu >> 4) & 63, b = wu >> 10, r32 = lane & 31, hh = lane >> 5;
    const size_t tokbase = (size_t)b * SEQ;
    float st[2], atot[2], cbr[2], cbi[2], csp[2];
#pragma unroll
    for (int cbh = 0; cbh < 2; ++cbh) { const int ch = 64 * n + 32 * cbh + r32;
        cbr[cbh] = P.b_rg[ch]; cbi[cbh] = P.b_ig[ch];
        const float l = P.lam[ch]; csp[cbh] = 8.f * LOG2E * (fmaxf(-l, 0.f) + log1pf(expf(-fabsf(l))));
        atot[cbh] = 1.f; float s = 0.f;
        st[cbh] = s; }
    u32x4 xn[16];
#define LRU_LOADX(TOK) do { _Pragma("unroll") for (int kk = 0; kk < 4; ++kk) { const int ch0 = 64 * n + 16 * kk + 8 * hh; _Pragma("unroll") for (int k = 0; k < 4; ++k) { const int tt = (TOK) - 3 + k; \
        u32x4 xv = {0u, 0u, 0u, 0u}; if (tt >= 0) xv = *(const u32x4*)(UX + (tokbase + tt) * DM + ch0); xn[kk * 4 + k] = xv; } } } while (0)
#define LRU_CONV() do { _Pragma("unroll") for (int kk = 0; kk < 4; ++kk) { const int ch0 = 64 * n + 16 * kk + 8 * hh; \
        f32x4 c0 = *(const f32x4*)(cbp + ch0), c1 = *(const f32x4*)(cbp + ch0 + 4); \
        _Pragma("unroll") for (int k = 0; k < 4; ++k) { const u32x4 xv = xn[kk * 4 + k]; \
            const f32x4 w0 = *(const f32x4*)(cwp + k * DM + ch0), w1 = *(const f32x4*)(cwp + k * DM + ch0 + 4); \
            c0[0] += w0[0] * bflo(xv.x); c0[1] += w0[1] * bfhi(xv.x); c0[2] += w0[2] * bflo(xv.y); c0[3] += w0[3] * bfhi(xv.y); \
            c1[0] += w1[0] * bflo(xv.z); c1[1] += w1[1] * bfhi(xv.z); c1[2] += w1[2] * bflo(xv.w); c1[3] += w1[3] * bfhi(xv.w); } \
        af[kk] = __builtin_bit_cast(bf16x8, pack8(c0, c1)); } } while (0)
    bf16x8 af[4];
    { const float* cwp = P.conv_w; const float* cbp = P.conv_b; LRU_LOADX(chunk * 128 + r32); LRU_CONV(); }
#pragma unroll 1
    for (int sb = 0; sb < 4; ++sb) {
        const int t0s = chunk * 128 + sb * 32;
        const float* cwp = P.conv_w; const float* cbp = P.conv_b; const bf16_t* wgf = WGF; int hl = hh;
        asm volatile("" : "+s"(cwp), "+s"(cbp), "+s"(wgf), "+v"(hl));
#pragma unroll 1
        for (int cbh = 0; cbh < 2; ++cbh) {
            const int col = 32 * cbh + r32, ch = 64 * n + col;
            const float k_br = cbh ? cbr[1] : cbr[0], k_bi = cbh ? cbi[1] : cbi[0], k_sp = cbh ? csp[1] : csp[0];
            bf16x8 wbr[4], wbi[4];
#pragma unroll
            for (int kk = 0; kk < 4; ++kk) { wbr[kk] = *(const bf16x8*)(wgf + ((size_t)((((n * 2 + 0) * 2 + cbh) * 4 + kk) * 64) + lane) * 8);
                wbi[kk] = *(const bf16x8*)(wgf + ((size_t)((((n * 2 + 1) * 2 + cbh) * 4 + kk) * 64) + lane) * 8); }
            f32x16 dr, di, dc;
#pragma unroll
            for (int e = 0; e < 16; ++e) { dr[e] = 0.f; di[e] = 0.f; dc[e] = 0.f; }
#pragma unroll
            for (int kk = 0; kk < 4; ++kk) {
                u32x4 idv = {0u, 0u, 0u, 0u};
                if ((col >> 3) == 2 * kk + hl) { const unsigned one = (col & 1) ? 0x3F800000u : 0x00003F80u; const int pi = (col & 7) >> 1;
                    idv.x = pi == 0 ? one : 0u; idv.y = pi == 1 ? one : 0u; idv.z = pi == 2 ? one : 0u; idv.w = pi == 3 ? one : 0u; }
                dr = __builtin_amdgcn_mfma_f32_32x32x16_bf16(af[kk], wbr[kk], dr, 0, 0, 0);
                di = __builtin_amdgcn_mfma_f32_32x32x16_bf16(af[kk], wbi[kk], di, 0, 0, 0);
                dc = __builtin_amdgcn_mfma_f32_32x32x16_bf16(af[kk], __builtin_bit_cast(bf16x8, idv), dc, 0, 0, 0);
            }
            __builtin_amdgcn_sched_barrier(0);
#pragma unroll
            for (int k2 = 0; k2 < 2; ++k2)
#pragma unroll
                for (int k = 0; k < 4; ++k) { const int kk = 2 * cbh + k2;
                    __builtin_amdgcn_global_load_lds((const unsigned*)(UX + (tokbase + t0s + 32 + r32 - 3 + k) * DM + 64 * n + 16 * kk + 8 * hh), (LAS unsigned*)(wlds + (kk * 4 + k) * 1024), 16, 0, 0); }
            __builtin_amdgcn_sched_barrier(0);
            float a[16], uu[16];
#pragma unroll
            for (int r = 0; r < 16; ++r) { const float rg = fsigmoid(dr[r] + k_br), di1 = 1.f + __builtin_amdgcn_exp2f(-LOG2E * (di[r] + k_bi));
                const float av = __builtin_amdgcn_exp2f(-k_sp * rg);
                const float y = fmaxf(1.f - av * av, 1e-30f);
                a[r] = av; uu[r] = (y * __builtin_amdgcn_rsqf(y * di1 * di1)) * dc[r]; }
            __builtin_amdgcn_sched_barrier(0);
            bf16_t* ugb = UG + (tokbase + t0s) * DM + 64 * n; bf16_t* ylb = YL + (tokbase + t0s) * DM + 64 * n;
            unsigned lofs = (unsigned)(4 * hh * DM + 32 * cbh + r32); asm volatile("" : "+v"(lofs));
            unsigned ugv[16];
            if (PASS_B) {
#pragma unroll
                for (int r = 0; r < 16; ++r) ugv[r] = (unsigned)ugb[lofs + (unsigned)(((r & 3) + 8 * (r >> 2)) * DM)];
            }
            __builtin_amdgcn_sched_barrier(0);
            float Ag[4], Hg[4], pA[4], pH[4], cin[4], pin[4];
#pragma unroll
            for (int g = 0; g < 4; ++g) { Ag[g] = (a[4 * g] * a[4 * g + 1]) * (a[4 * g + 2] * a[4 * g + 3]);
                Hg[g] = ((uu[4 * g] * a[4 * g + 1] + uu[4 * g + 1]) * a[4 * g + 2] + uu[4 * g + 2]) * a[4 * g + 3] + uu[4 * g + 3]; }
#pragma unroll
            for (int g = 0; g < 4; ++g) { pA[g] = __shfl_xor(Ag[g], 32); pH[g] = __shfl_xor(Hg[g], 32); }
            float run = cbh ? st[1] : st[0], ap = cbh ? atot[1] : atot[0];
#pragma unroll
            for (int g = 0; g < 4; ++g) { const float A0 = hh ? pA[g] : Ag[g], H0 = hh ? pH[g] : Hg[g], A1 = hh ? Ag[g] : pA[g], H1 = hh ? Hg[g] : pH[g];
                const float c0 = run; run = A0 * run + H0; const float c1 = run; run = A1 * run + H1; cin[g] = hh ? c1 : c0;
                const float q1 = ap * A0; pin[g] = hh ? q1 : ap; ap = q1 * A1; }
            if (cbh) { st[1] = run; atot[1] = ap; } else { st[0] = run; atot[0] = ap; }
            if (PASS_B) {
#pragma unroll
                for (int g = 0; g < 4; ++g) { float hv = cin[g], pv = pin[g];
#pragma unroll
                    for (int i = 0; i < 4; ++i) { const int r = 4 * g + i; hv = a[r] * hv + uu[r]; pv *= a[r];
                        const unsigned o = lofs + (unsigned)(((r & 3) + 8 * (r >> 2)) * DM); const float ug = bflo(ugv[r]);
                        const unsigned w = cvt_pk(hv * ug, pv * ug);
                        ylb[o] = (bf16_t)(w & 0xffffu); ugb[o] = (bf16_t)(w >> 16); } }
            }
        }
        if (sb < 3) {
            asm volatile("s_waitcnt vmcnt(0)" ::: "memory");
#pragma unroll
            for (int q = 0; q < 16; ++q) xn[q] = *(const LAS u32x4*)(wlds + q * 1024 + lane * 16);
            LRU_CONV(); }
    }
#undef LRU_LOADX
#undef LRU_CONV
    asm volatile("s_waitcnt vmcnt(0)" ::: "memory");
    {
#pragma unroll
        for (int cbh = 0; cbh < 2; ++cbh) { const int ch = 64 * n + 32 * cbh + r32; float* ag = AGG + ((size_t)(b * 64 + chunk) * 2) * DM + ch;
            if (hh == 0) { ag[0] = atot[cbh]; ag[DM] = st[cbh]; } }
    }
}

__device__ __forceinline__ void lru_light(const Ptrs& P, int wu, int lane) {
    unsigned char* ws = P.ws;
    bf16_t* YL = (bf16_t*)(ws + WS_XN); const bf16_t* PU = (const bf16_t*)(ws + WS_UG); const float* AGG = (const float*)(ws + WS_AGG);
    const int n = wu & 15, chunk = (wu >> 4) & 63, b = wu >> 10, ch0 = 64 * n + 8 * (lane & 7);
    if (chunk == 0) return;
    f32x4 s0 = {0.f, 0.f, 0.f, 0.f}, s1 = {0.f, 0.f, 0.f, 0.f};
    for (int c0 = 0; c0 < chunk; c0 += 4) { f32x4 A0[4], A1[4], H0[4], H1[4];
#pragma unroll
        for (int j = 0; j < 4; ++j) { const bool ok = c0 + j < chunk; const float* ag = AGG + ((size_t)(b * 64 + (ok ? c0 + j : 0)) * 2) * DM + ch0;
            A0[j] = *(const f32x4*)ag; A1[j] = *(const f32x4*)(ag + 4); H0[j] = *(const f32x4*)(ag + DM); H1[j] = *(const f32x4*)(ag + DM + 4);
            if (!ok) { A0[j] = (f32x4){1.f, 1.f, 1.f, 1.f}; A1[j] = A0[j]; H0[j] = (f32x4){0.f, 0.f, 0.f, 0.f}; H1[j] = H0[j]; } }
#pragma unroll
        for (int j = 0; j < 4; ++j) { s0 = A0[j] * s0 + H0[j]; s1 = A1[j] * s1 + H1[j]; } }
    const size_t base = ((size_t)b * SEQ + chunk * 128 + (lane >> 3)) * DM + ch0;
#pragma unroll 4
    for (int i = 0; i < 16; ++i) { const size_t o = base + (size_t)(8 * i) * DM;
        const u32x4 y = *(const u32x4*)(YL + o), p = *(const u32x4*)(PU + o);
        f32x4 v0, v1;
        v0[0] = bflo(y.x) + bflo(p.x) * s0[0]; v0[1] = bfhi(y.x) + bfhi(p.x) * s0[1]; v0[2] = bflo(y.y) + bflo(p.y) * s0[2]; v0[3] = bfhi(y.y) + bfhi(p.y) * s0[3];
        v1[0] = bflo(y.z) + bflo(p.z) * s1[0]; v1[1] = bfhi(y.z) + bfhi(p.z) * s1[1]; v1[2] = bflo(y.w) + bflo(p.w) * s1[2]; v1[3] = bfhi(y.w) + bfhi(p.w) * s1[3];
        *(u32x4*)(YL + o) = pack8(v0, v1); }
}

__device__ __forceinline__ void sb_block(const f32x16& z, float (&om)[16], float (&be)[16], int lim) {
#pragma unroll
    for (int r = 0; r < 16; ++r) { const float e = __builtin_amdgcn_exp2f(LOG2E * fminf(z[r], 60.f)), o = __builtin_amdgcn_rcpf(1.f + e);
        const bool ok = ((r & 3) + 8 * (r >> 2)) < lim; om[r] = ok ? o : 1.f; be[r] = ok ? e * o : 0.f; }
}
template <bool DRY>
__device__ __forceinline__ void attn_unit(const Ptrs& P, LAS unsigned char* wlds  , int wu, int lane) {
    unsigned char* ws = P.ws;
    const bf16_t* Kb = (const bf16_t*)(ws + WS_K); const bf16_t* VT = (const bf16_t*)(ws + WS_VT); bf16_t* QO = (bf16_t*)(ws + WS_Q);
    const int qb = wu & 255, h = (wu >> 8) & 15, b = wu >> 12, r32 = lane & 31, hh = lane >> 5, t0 = qb * 32, tq = t0 + r32;
    const size_t rowbase = (size_t)b * SEQ;
    bf16x8 qf[4];
    { const bf16_t* qp = QO + (rowbase + tq) * DM + h * HD + 8 * hh;
#pragma unroll
        for (int kk = 0; kk < 4; ++kk) qf[kk] = *(const bf16x8*)(qp + 16 * kk); }
    f32x16 o0, o1;
#pragma unroll
    for (int e = 0; e < 16; ++e) { o0[e] = 0.f; o1[e] = 0.f; }
    float C2 = 0.f;
    const int lrow = lane >> 3, lch = lane & 7;
    const bf16_t* kg = Kb + (rowbase + lrow) * DM + h * HD + 8 * lch;
    const bf16_t* vg = VT + (size_t)(h * HD + lrow) * MT + rowbase + 8 * lch;
    LAS unsigned char* kl = wlds; LAS unsigned char* vl = wlds + 9216;
    const int wofs = lrow * 144 + lch * 16, rofs = r32 * 144 + hh * 16;
    u32x4 kr[8];
    { const bf16_t* kp = kg + (size_t)((t0 >> 6) * 64) * DM;
#pragma unroll
        for (int i2 = 0; i2 < 8; ++i2) kr[i2] = *(const u32x4*)(kp + (size_t)(8 * i2) * DM); }
    u32x4 vr[8];
#pragma unroll
    for (int i2 = 0; i2 < 8; ++i2) vr[i2] = *(const u32x4*)(vg + (size_t)(8 * i2) * MT + (t0 >> 6) * 64);
#pragma unroll 1
    for (int kt = t0 >> 6; kt >= 0; --kt) {
        const int s0 = kt * 64;
#pragma unroll
        for (int i2 = 0; i2 < 8; ++i2) *(LAS u32x4*)(kl + wofs + i2 * 8 * 144) = kr[i2];
        f32x16 p0, p1;
#pragma unroll
        for (int e = 0; e < 16; ++e) { p0[e] = 0.f; p1[e] = 0.f; }
#pragma unroll
        for (int kk = 0; kk < 4; ++kk) { const bf16x8 k0 = *(const LAS bf16x8*)(kl + rofs + kk * 32), k1 = *(const LAS bf16x8*)(kl + rofs + 32 * 144 + kk * 32);
            p0 = __builtin_amdgcn_mfma_f32_32x32x16_bf16(k0, qf[kk], p0, 0, 0, 0); p1 = __builtin_amdgcn_mfma_f32_32x32x16_bf16(k1, qf[kk], p1, 0, 0, 0); }
        if (kt > 0) { const bf16_t* kp = kg + (size_t)(s0 - 64) * DM;
#pragma unroll
            for (int i2 = 0; i2 < 8; ++i2) kr[i2] = *(const u32x4*)(kp + (size_t)(8 * i2) * DM); }
        float om0[16], om1[16], be0[16], be1[16];
        sb_block(p0, om0, be0, tq - s0 - 4 * hh); sb_block(p1, om1, be1, tq - s0 - 32 - 4 * hh);
        float G0[4], G1[4], Q0[4], Q1[4], off0[4], off1[4];
#pragma unroll
        for (int g = 0; g < 4; ++g) { G0[g] = (om0[4 * g] * om0[4 * g + 1]) * (om0[4 * g + 2] * om0[4 * g + 3]); G1[g] = (om1[4 * g] * om1[4 * g + 1]) * (om1[4 * g + 2] * om1[4 * g + 3]); }
#pragma unroll
        for (int g = 0; g < 4; ++g) { Q0[g] = __shfl_xor(G0[g], 32); Q1[g] = __shfl_xor(G1[g], 32); }
        float run = __builtin_amdgcn_exp2f(C2);
#pragma unroll
        for (int g = 3; g >= 0; --g) { const float hi = hh ? G1[g] : Q1[g], lo = hh ? Q1[g] : G1[g]; const float oh = run; run *= hi; const float ol = run; run *= lo; off1[g] = hh ? oh : ol; }
#pragma unroll
        for (int g = 3; g >= 0; --g) { const float hi = hh ? G0[g] : Q0[g], lo = hh ? Q0[g] : G0[g]; const float oh = run; run *= hi; const float ol = run; run *= lo; off0[g] = hh ? oh : ol; }
#pragma unroll
        for (int g = 3; g >= 0; --g) { float cum = off1[g];
#pragma unroll
            for (int i = 3; i >= 0; --i) { const int r = 4 * g + i; p1[r] = be1[r] * cum; cum *= om1[r]; } }
#pragma unroll
        for (int g = 3; g >= 0; --g) { float cum = off0[g];
#pragma unroll
            for (int i = 3; i >= 0; --i) { const int r = 4 * g + i; p0[r] = be0[r] * cum; cum *= om0[r]; } }
        { float tp = 1.f;
#pragma unroll
            for (int g = 0; g < 4; ++g) tp *= (G0[g] * Q0[g]) * (G1[g] * Q1[g]);
            C2 += __builtin_amdgcn_logf(tp); }
#pragma unroll
        for (int i2 = 0; i2 < 8; ++i2) *(LAS u32x4*)(vl + wofs + i2 * 8 * 144) = vr[i2];
        if (kt > 0) {
#pragma unroll
            for (int i2 = 0; i2 < 8; ++i2) vr[i2] = *(const u32x4*)(vg + (size_t)(8 * i2) * MT + s0 - 64); }
#pragma unroll
        for (int kb = 0; kb < 2; ++kb)
#pragma unroll
            for (int s = 0; s < 2; ++s) { u32x4 pw;
                if (kb == 0) { pw.x = cvt_pk(p0[8 * s], p0[8 * s + 1]); pw.y = cvt_pk(p0[8 * s + 2], p0[8 * s + 3]); pw.z = cvt_pk(p0[8 * s + 4], p0[8 * s + 5]); pw.w = cvt_pk(p0[8 * s + 6], p0[8 * s + 7]); }
                else { pw.x = cvt_pk(p1[8 * s], p1[8 * s + 1]); pw.y = cvt_pk(p1[8 * s + 2], p1[8 * s + 3]); pw.z = cvt_pk(p1[8 * s + 4], p1[8 * s + 5]); pw.w = cvt_pk(p1[8 * s + 6], p1[8 * s + 7]); }
                const bf16x8 pa = __builtin_bit_cast(bf16x8, pw);
                const bf16x8 va = *(const LAS bf16x8*)(vl + rofs + (32 * kb + 16 * s) * 2), vb = *(const LAS bf16x8*)(vl + rofs + 32 * 144 + (32 * kb + 16 * s) * 2);
                o0 = __builtin_amdgcn_mfma_f32_32x32x16_bf16(pa, va, o0, 0, 0, 0);
                o1 = __builtin_amdgcn_mfma_f32_32x32x16_bf16(pa, vb, o1, 0, 0, 0); }
        if (__builtin_amdgcn_ballot_w64(C2 >= -150.f) == 0ull) break;
    }
    if (DRY) { if (C2 != 12345.678f) return; }
    bf16_t* op = QO + (rowbase + t0) * DM + h * HD + r32;
#pragma unroll
    for (int r = 0; r < 16; ++r) { bf16_t* o = op + (size_t)crow(r, hh) * DM; o[0] = (bf16_t)(cvt_pk(o0[r], 0.f) & 0xffffu); o[32] = (bf16_t)(cvt_pk(o1[r], 0.f) & 0xffffu); }
}

struct Args { const float* in[21]; float* out; unsigned char* ws; int ph_lo, ph_hi; };
__global__ void __launch_bounds__(NWAVES * 64, 2) mk_fwd(Args args) {
    extern __shared__ __attribute__((aligned(16))) unsigned char lds_raw[];
    LAS unsigned char* lds = (LAS unsigned char*)lds_raw;
    cg::grid_group grid = cg::this_grid();
    const int G = gridDim.x, bx = blockIdx.x, NGW = G * NWAVES;
#define PHASE_IDS int tid_ = threadIdx.x; asm volatile("" : "+v"(tid_)); const int lane = tid_ & 63, wave = __builtin_amdgcn_readfirstlane(tid_ >> 6), gw = bx * NWAVES + wave; (void)lane; (void)gw;
    Ptrs P;
    P.x = args.in[0]; P.p = args.in[1]; P.g_mix = args.in[2]; P.w_in = args.in[3]; P.conv_w = args.in[4]; P.conv_b = args.in[5]; P.w_rg = args.in[6]; P.b_rg = args.in[7];
    P.w_ig = args.in[8]; P.b_ig = args.in[9]; P.lam = args.in[10]; P.w_brl = args.in[11]; P.w_bra = args.in[12]; P.w_out = args.in[13]; P.g_mlp = args.in[14]; P.w_up = args.in[15];
    P.w_dn = args.in[16]; P.g_ple = args.in[17]; P.w_pg = args.in[18]; P.w_ple = args.in[19]; P.g_fin = args.in[20]; P.out = args.out; P.ws = args.ws;
    unsigned char* ws = args.ws;
    const int lo = args.ph_lo, hi = args.ph_hi;
#ifndef REPMASK
#define REPMASK 0
#endif
#define NREP(k) (((REPMASK >> (k)) & 1) ? 2 : 1)
#ifndef PHMASK
#define PHMASK 0x3ff
#endif
#define IN(k) (((PHMASK >> (k)) & 1) && lo <= (k) && (k) < hi)
    volatile LAS unsigned* MISC = (volatile LAS unsigned*)(lds + 147456);
    if (threadIdx.x < 64) MISC[threadIdx.x] = 0u;
    __syncthreads();
    XcdBarrier bar = xcd_barrier_post((unsigned*)(ws + WS_BAR), MISC + 8);
    if (args.ph_hi > 1000) grid.sync();
#define SEAM(k) do { if (IN(k) && IN((k) + 1)) { xcd_barrier(bar); } } while (0)
    bf16_t* GL = (bf16_t*)P.out; bf16_t* GA = GL + (size_t)MT * DM;

    for (int rep_ = 0; rep_ < NREP(0); ++rep_) { if (rep_) xcd_barrier(bar);
    if (IN(0)) { PHASE_IDS phase0<0>(P, (LAS float*)(lds + wave * 18432), gw, NGW, lane); __syncthreads(); }
    }
    SEAM(0);
    for (int rep_ = 0; rep_ < NREP(1); ++rep_) { if (rep_) xcd_barrier(bar);
    if (IN(1)) {
        pg8::Sched2 S; S.A0 = (const char*)(ws + WS_XN); S.B0 = (const char*)(ws + WS_WIN); S.nM0 = MT / 256; S.nN0 = NMAIN / 256;
        S.A1 = (const char*)(ws + WS_WIN) + (size_t)NMAIN * DM * 2; S.B1 = (const char*)(ws + WS_XN); S.nM1 = DM / 256; S.nN1 = MT / 256; S.mode = 0; S.G = G; S.c = bx; S.tstep = (size_t)256 * DM * 2;
        EpiIn E{(bf16_t*)(ws + WS_UX), (bf16_t*)(ws + WS_UG), (bf16_t*)(ws + WS_Q), (bf16_t*)(ws + WS_K), GL, GA, (bf16_t*)(ws + WS_VT)};
        pg8::gemm_phase<EpiIn, pg8::Sched2, true, true>(lds, DM, S, E);
    }
    }
    SEAM(1);
    {
    if (IN(2)) { PHASE_IDS
        const bool conv_first = (wave & 4) != 0;
#pragma unroll 1
        for (int step = 0; step < 2; ++step) {
            int l2 = lane; asm volatile("" : "+v"(l2));
            if ((step == 0) == conv_first) phase0<1>(P, (LAS float*)(lds + wave * 18432), gw, NGW, l2);
            else { for (int wu = gw; wu < NB * 64 * 16; wu += NGW) lru_unit<true>(P, lds + wave * 18432, wu, l2); } } }
    }
    SEAM(2);
    if (IN(3)) {
        PHASE_IDS
        const bool attn_first = (wave & 4) != 0;
#pragma unroll 1
        for (int step = 0; step < 2; ++step) {
            if ((step == 0) == attn_first) {
                if ((REPMASK >> 10) & 1) { for (int wu = gw; wu < NB * NH * (SEQ / 32); wu += NGW) attn_unit<true>(P, lds + wave * 18432, wu, lane); }
                for (int wu = gw; wu < NB * NH * (SEQ / 32); wu += NGW) attn_unit<false>(P, lds + wave * 18432, wu, lane);
            } else {
                for (int wu = gw; wu < NB * 64 * 16; wu += NGW) lru_light(P, wu, lane);
            } }
    }
    SEAM(3);
    for (int rep_ = 0; rep_ < NREP(4); ++rep_) { if (rep_) xcd_barrier(bar);
    if (IN(4)) {
        pg8::Sched2 S; S.A0 = (const char*)(ws + WS_XN); S.B0 = (const char*)(ws + WS_WBRL); S.nM0 = MT / 256; S.nN0 = DM / 256;
        S.A1 = (const char*)(ws + WS_Q); S.B1 = (const char*)(ws + WS_WBRA); S.nM1 = MT / 256; S.nN1 = DM / 256; S.mode = 1; S.G = G; S.c = bx; S.tstep = (size_t)256 * DM * 2;
        EpiBr E{(bf16_t*)(ws + WS_UX), GL, GA};
        pg8::gemm_phase<EpiBr, pg8::Sched2, true, true>(lds, DM, S, E);
    }
    }
    SEAM(4);
    for (int rep_ = 0; rep_ < NREP(5); ++rep_) { if (rep_) xcd_barrier(bar);
    if (IN(5)) {
        pg8::Sched2 S; S.A0 = (const char*)(ws + WS_UX); S.B0 = (const char*)(ws + WS_WOUT); S.nM0 = MT / 256; S.nN0 = DM / 256; S.A1 = S.A0; S.B1 = S.B0; S.nM1 = 0; S.nN1 = 0; S.mode = 0; S.G = G; S.c = bx; S.tstep = (size_t)256 * DM * 2;
        EpiRes<false> E{(const void*)P.x, (bf16_t*)(ws + WS_XN), (float*)(ws + WS_SS1)};
        pg8::gemm_phase<EpiRes<false>, pg8::Sched2, true, true>(lds, DM, S, E);
    }
    }
    SEAM(5);
    for (int rep_ = 0; rep_ < NREP(6); ++rep_) { if (rep_) xcd_barrier(bar);
    if (IN(6)) {
        pg8::Sched2 S; S.A0 = (const char*)(ws + WS_XN); S.B0 = (const char*)(ws + WS_WUP); S.nM0 = MT / 256; S.nN0 = FF / 256; S.A1 = S.A0; S.B1 = S.B0; S.nM1 = 0; S.nN1 = 0; S.mode = 0; S.G = G; S.c = bx; S.tstep = (size_t)256 * DM * 2;
        EpiUp E{(bf16_t*)(ws + WS_UG), (const float*)(ws + WS_SS1)};
        pg8::gemm_phase<EpiUp, pg8::Sched2, true, true>(lds, DM, S, E);
    }
    }
    SEAM(6);
    if (IN(7)) {
        pg8::Sched2 S; S.A0 = (const char*)(ws + WS_UG); S.B0 = (const char*)(ws + WS_WDN); S.nM0 = MT / 256; S.nN0 = DM / 256; S.A1 = S.A0; S.B1 = S.B0; S.nM1 = 0; S.nN1 = 0; S.mode = 0; S.G = G; S.c = bx; S.tstep = (size_t)256 * FF * 2;
        EpiRes<true> E{(const void*)(ws + WS_XN), (bf16_t*)(ws + WS_UX), (float*)(ws + WS_SS2)};
        pg8::gemm_phase<EpiRes<true>, pg8::Sched2, true, true>(lds, FF, S, E);
    }
    SEAM(7);
    if (IN(8)) {
        { pg8::Sched2 S; S.A0 = (const char*)(ws + WS_PB); S.B0 = (const char*)(ws + WS_WPLE); S.nM0 = MT / 256; S.nN0 = DM / 256; S.A1 = S.A0; S.B1 = S.B0; S.nM1 = 0; S.nN1 = 0; S.mode = 0; S.G = G; S.c = bx; S.tstep = (size_t)256 * PLE * 2;
            EpiE E{(bf16_t*)(ws + WS_XN)};
            int kple = PLE; asm volatile("" : "+s"(kple));
            pg8::gemm_phase<EpiE, pg8::Sched2, true, true>(lds, kple, S, E); }
        __syncthreads();
        { pg8::Sched2 S; S.A0 = (const char*)(ws + WS_UX); S.B0 = (const char*)(ws + WS_WPG); S.nM0 = MT / 256; S.nN0 = DM / 256; S.A1 = S.A0; S.B1 = S.B0; S.nM1 = 0; S.nN1 = 0; S.mode = 0; S.G = G; S.c = bx; S.tstep = (size_t)256 * DM * 2;
            EpiPle E{(const bf16_t*)(ws + WS_UX), (bf16_t*)(ws + WS_XN), (const float*)(ws + WS_SS2), (float*)(ws + WS_SS3)};
            pg8::gemm_phase<EpiPle, pg8::Sched2, true, true>(lds, DM, S, E); }
    }
    SEAM(8);
    if (IN(9)) {
        PHASE_IDS
        const float* ss = (const float*)(ws + WS_SS3);
        const bf16_t* X3 = (const bf16_t*)(ws + WS_XN);
        for (int m = gw; m < MT; m += NGW) { const float rs = row_rstd(ss, m);
            const u32x4* xr = (const u32x4*)(X3 + (size_t)m * DM) + lane; f32x4* orow = (f32x4*)(P.out + (size_t)m * DM); const f32x4* gr = (const f32x4*)P.g_fin;
#pragma unroll
            for (int j = 0; j < 2; ++j) { const u32x4 w = xr[64 * j]; const int c4 = (64 * j + lane) * 2; const f32x4 ga = gr[c4], gb = gr[c4 + 1];
                f32x4 a, b2; a[0] = bflo(w.x) * rs * ga[0]; a[1] = bfhi(w.x) * rs * ga[1]; a[2] = bflo(w.y) * rs * ga[2]; a[3] = bfhi(w.y) * rs * ga[3];
                b2[0] = bflo(w.z) * rs * gb[0]; b2[1] = bfhi(w.z) * rs * gb[1]; b2[2] = bflo(w.w) * rs * gb[2]; b2[3] = bfhi(w.w) * rs * gb[3];
                orow[c4] = a; orow[c4 + 1] = b2; } }
    }
#undef IN
#undef SEAM
}

extern "C" void kernel_launch(void* const* d_in, const int* in_sizes, int n_in, void* d_out, int out_size, void* d_ws, size_t ws_size, hipStream_t stream) {
    static int grid = 0;
    if (grid == 0) {
        if (n_in != 21 || out_size != MT * DM || ws_size < WS_END) { fprintf(stderr, "kernel_launch: unexpected problem shape (n_in %d, out %d, ws %zu)\n", n_in, out_size, ws_size); grid = -1; return; }
        int dev = 0, cus = 0, per_cu = 0;
        (void)hipGetDevice(&dev); (void)hipDeviceGetAttribute(&cus, hipDeviceAttributeMultiprocessorCount, dev);
        (void)hipFuncSetAttribute((const void*)mk_fwd, hipFuncAttributeMaxDynamicSharedMemorySize, LDS_BYTES);
        if (hipOccupancyMaxActiveBlocksPerMultiprocessor(&per_cu, (const void*)mk_fwd, NWAVES * 64, LDS_BYTES) != hipSuccess || per_cu < 1) per_cu = 1;
        (void)hipGetLastError();
        if (cus <= 0) cus = 256;
        grid = cus * per_cu;
    }
    if (grid < 0) return;
    Args a{};
    for (int i = 0; i < 21; ++i) a.in[i] = (const float*)d_in[i];
    a.out = (float*)d_out; a.ws = (unsigned char*)d_ws;
#if MK_PER_PHASE
    for (int ph = 0; ph < NPHASE; ++ph) { a.ph_lo = ph; a.ph_hi = ph + 1; hipLaunchKernelGGL(mk_fwd, dim3(grid), dim3(NWAVES * 64), LDS_BYTES, stream, a); }
#else
    a.ph_lo = 0; a.ph_hi = NPHASE;
    (void)hipMemsetAsync((unsigned char*)d_ws + WS_BAR, 0, BAR_BYTES, stream);
    void* params[] = {(void*)&a};
    hipError_t e = hipLaunchCooperativeKernel((const void*)mk_fwd, dim3(grid), dim3(NWAVES * 64), params, LDS_BYTES, stream);
    if (e != hipSuccess) fprintf(stderr, "cooperative launch failed: %s (grid %d)\n", hipGetErrorString(e), grid);
#endif
}
```

```cpp
#include <hip/hip_runtime.h>
#include <hip/hip_cooperative_groups.h>
#include <cstdio>
#include <cstdint>
namespace cg = cooperative_groups;

#ifndef MK_PER_PHASE
#define MK_PER_PHASE 0
#endif

namespace pg8 {
#define PG8_LAS __attribute__((address_space(3)))
typedef unsigned short bf16_t;
typedef short bf16x8 __attribute__((ext_vector_type(8)));
typedef float f32x4 __attribute__((ext_vector_type(4)));
typedef unsigned u32x4 __attribute__((ext_vector_type(4)));
constexpr int BM = 256, BK = 64, HALF = 128, HTB = HALF * BK * 2  , STAGE_BYTES = 8 * HTB, NXCD = 8, WGM = 4;

__host__ __device__ __forceinline__ int lds_byte(int r, int c) { const int st = (r >> 4) * 2 + (c >> 5), rr = r & 15, cc = c & 31, ob = rr * 64 + cc * 2; return st * 1024 + (ob ^ (((ob >> 9) & 1) << 5)); }
__host__ __device__ __forceinline__ void stage_rc(int b, int& R, int& C) { const int st = b / 1024, sb = b % 1024, swz = sb ^ (((sb >> 9) & 1) << 5); R = (st >> 1) * 16 + swz / 64; C = (st & 1) * 32 + (swz % 64) / 2; }
__host__ __device__ __forceinline__ int perm32(int rho) { const int n = rho >> 4, i = rho & 15; return 8 * (i >> 2) + 4 * n + (i & 3); }

struct Unit { const char* A; const char* B; int pm, pn, kind; };

__device__ __forceinline__ void swz_tile(int wgid, int nM, int nN, int& pm, int& pn) {
    const int nwg = nM * nN;
    { const int q = nwg / NXCD, r = nwg % NXCD, xcd = wgid % NXCD, off = wgid / NXCD; wgid = (xcd < r ? xcd * (q + 1) : r * (q + 1) + (xcd - r) * q) + off; }
    const int nig = WGM * nN, gid = wgid / nig, fm = gid * WGM, gsz = (nM - fm) < WGM ? (nM - fm) : WGM;
    pm = fm + ((wgid % nig) % gsz); pn = (wgid % nig) / gsz;
}
struct Sched2 {
    const char *A0, *B0, *A1, *B1; int nM0, nN0, nM1, nN1, mode, G, c; size_t tstep;
    __device__ __forceinline__ bool next(int i, Unit& u) const {
        int pm, pn;
        if (mode == 0) {
            const int L = i * G + c, n0 = nM0 * nN0;
            if (L < n0) { swz_tile(L, nM0, nN0, pm, pn); u.pm = pm; u.pn = pn; u.kind = 0; u.A = A0 + (size_t)pm * tstep; u.B = B0 + (size_t)pn * tstep; return true; }
            const int L1 = L - n0; if (L1 >= nM1 * nN1) return false;
            swz_tile(L1, nM1, nN1, pm, pn); u.pm = pm; u.pn = pn; u.kind = 1; u.A = A1 + (size_t)pm * tstep; u.B = B1 + (size_t)pn * tstep; return true;
        } else {
            const int T = (i >> 1) * G + c; if (T >= nM0 * nN0) return false;
            swz_tile(T, nM0, nN0, pm, pn); u.pm = pm; u.pn = pn; u.kind = i & 1;
            u.A = ((i & 1) ? A1 : A0) + (size_t)pm * tstep; u.B = ((i & 1) ? B1 : B0) + (size_t)pn * tstep; return true;
        }
    }
};

template <class Epi, class Sched, bool ALIGN_EPI = false, bool SP2 = false, bool FP8 = false>
__device__ __forceinline__ void gemm_phase(PG8_LAS unsigned char* lds, const int K, const Sched& S, const Epi& E) {
    int tid_ = threadIdx.x; asm volatile("" : "+v"(tid_));
    const int tid = tid_, wid = __builtin_amdgcn_readfirstlane(tid >> 6), lane = tid & 63, wr = wid >> 2, wc = wid & 3, fr = lane & 15, fq = lane >> 4;
    const int nt = K / BK;
    unsigned voffA[2], voffB[2];
#pragma unroll
    for (int i = 0; i < 2; ++i) { int R, C; stage_rc(tid * 16 + i * 8192, R, C); const int Rb = Epi::PERM ? ((R & ~31) + perm32(R & 31)) : R;
        voffA[i] = (unsigned)(R * K + C) * 2u; voffB[i] = (unsigned)(Rb * K + C) * 2u; }
    const size_t kstep = (size_t)(BK * 2);
    const size_t hstep = (size_t)HALF * K * 2;
    const unsigned ldsw = (unsigned)wid * 1024u;
    const int aoff = lds_byte(wr * 64 + fr, fq * 8), boff = lds_byte(wc * 32 + fr, fq * 8);
#define PG8_SA(b, h) (((b) * 2 + (h)) * HTB)
#define PG8_SB(b, h) ((4 + (b) * 2 + (h)) * HTB)
#define PG8_STAGE(bufoff, gbase, voff) do { _Pragma("unroll") for (int _i = 0; _i < 2; ++_i) \
        __builtin_amdgcn_global_load_lds((const unsigned*)((const char*)(gbase) + (voff)[_i]), (PG8_LAS unsigned*)(lds + (bufoff) + ldsw + _i * 8192), 16, 0, 0); } while (0)
#define PG8_LDA(dst, b, h) do { _Pragma("unroll") for (int m = 0; m < 4; ++m) _Pragma("unroll") for (int k = 0; k < 2; ++k) dst[m][k] = *(const PG8_LAS bf16x8*)(lds + PG8_SA(b, h) + aoff + m * 2048 + k * 1024); } while (0)
#define PG8_LDB(dst, b, h) do { _Pragma("unroll") for (int n = 0; n < 2; ++n) _Pragma("unroll") for (int k = 0; k < 2; ++k) dst[n][k] = *(const PG8_LAS bf16x8*)(lds + PG8_SB(b, h) + boff + n * 2048 + k * 1024); } while (0)
#define PG8_MMA(ai, bj, At, Bt) do { __builtin_amdgcn_s_setprio(1); _Pragma("unroll") for (int m = 0; m < 4; ++m) _Pragma("unroll") for (int n = 0; n < 2; ++n) _Pragma("unroll") for (int k = 0; k < 2; ++k) { \
        if constexpr (FP8) { typedef long i64x2_t __attribute__((ext_vector_type(2))); const i64x2_t a2_ = __builtin_bit_cast(i64x2_t, At[m][k]), b2_ = __builtin_bit_cast(i64x2_t, Bt[n][k]); \
            acc[ai][bj][m][n] = __builtin_amdgcn_mfma_f32_16x16x32_fp8_fp8(b2_[0], a2_[0], acc[ai][bj][m][n], 0, 0, 0); acc[ai][bj][m][n] = __builtin_amdgcn_mfma_f32_16x16x32_fp8_fp8(b2_[1], a2_[1], acc[ai][bj][m][n], 0, 0, 0); } \
        else acc[ai][bj][m][n] = __builtin_amdgcn_mfma_f32_16x16x32_bf16(Bt[n][k], At[m][k], acc[ai][bj][m][n], 0, 0, 0); } __builtin_amdgcn_s_setprio(0); } while (0)
#define PG8_WAIT_V(n) asm volatile("s_waitcnt vmcnt(" #n ")" ::: "memory")
#define PG8_WAIT_L(n) asm volatile("s_waitcnt lgkmcnt(" #n ")" ::: "memory")
#define PG8_BAR __builtin_amdgcn_s_barrier()
#define PG8_SCHED __builtin_amdgcn_sched_barrier(0)
    Unit cur, nxt; int ui = 0;
    if (!S.next(0, cur)) return;
    f32x4 acc[2][2][4][2];
#pragma unroll
    for (int a = 0; a < 2; ++a)
#pragma unroll
        for (int b = 0; b < 2; ++b)
#pragma unroll
            for (int m = 0; m < 4; ++m)
#pragma unroll
                for (int n = 0; n < 2; ++n) acc[a][b][m][n] = (f32x4){0.f, 0.f, 0.f, 0.f};
    bf16x8 At[4][2], B0[2][2], B1[2][2];
    const char* cA = cur.A; const char* cB = cur.B;
    if constexpr (SP2) {
        PG8_STAGE(PG8_SB(0, 0), cB, voffB); PG8_STAGE(PG8_SB(0, 1), cB + hstep, voffB); PG8_STAGE(PG8_SA(0, 0), cA, voffA); PG8_STAGE(PG8_SA(0, 1), cA + hstep, voffA);
        if (wr == 1) PG8_BAR;
        PG8_WAIT_V(2); PG8_BAR;
        PG8_STAGE(PG8_SB(1, 0), cB + kstep, voffB); PG8_STAGE(PG8_SA(1, 0), cA + kstep, voffA); PG8_STAGE(PG8_SB(1, 1), cB + hstep + kstep, voffB);
        PG8_WAIT_V(6); PG8_BAR;
    } else {
        PG8_STAGE(PG8_SB(0, 0), cB, voffB); PG8_STAGE(PG8_SA(0, 0), cA, voffA); PG8_STAGE(PG8_SB(0, 1), cB + hstep, voffB); PG8_STAGE(PG8_SA(0, 1), cA + hstep, voffA);
        if (wr == 1) PG8_BAR;
        PG8_WAIT_V(4); PG8_BAR;
        PG8_STAGE(PG8_SB(1, 0), cB + kstep, voffB); PG8_STAGE(PG8_SA(1, 0), cA + kstep, voffA); PG8_STAGE(PG8_SB(1, 1), cB + hstep + kstep, voffB);
        PG8_WAIT_V(6); PG8_BAR;
    }
    for (;;) {
        const bool has_next = S.next(ui + 1, nxt);
        const char* nA = has_next ? nxt.A : cA; const char* nB = has_next ? nxt.B : cB;
        for (int t = 0; t < nt; t += 2) {
            const bool last = (t == nt - 2);
            const char* a1 = cA + (size_t)(t + 1) * kstep;
            const char* a2 = last ? nA : cA + (size_t)(t + 2) * kstep; const char* b2 = last ? nB : cB + (size_t)(t + 2) * kstep;
            const char* a3 = a2 + kstep; const char* b3 = b2 + kstep;
            if constexpr (SP2) {
            PG8_LDB(B0, 0, 0); PG8_LDB(B1, 0, 1); PG8_SCHED; PG8_LDA(At, 0, 0); PG8_STAGE(PG8_SA(1, 1), a1 + hstep, voffA);
            PG8_WAIT_V(8); PG8_WAIT_L(0); PG8_BAR; PG8_MMA(0, 0, At, B0); PG8_MMA(0, 1, At, B1); PG8_BAR; PG8_SCHED;
            PG8_LDA(At, 0, 1); PG8_STAGE(PG8_SB(0, 0), b2, voffB); PG8_STAGE(PG8_SB(0, 1), b2 + hstep, voffB); PG8_STAGE(PG8_SA(0, 0), a2, voffA);
            PG8_WAIT_V(8); PG8_WAIT_L(0); PG8_BAR; PG8_MMA(1, 0, At, B0); PG8_MMA(1, 1, At, B1); PG8_BAR; PG8_SCHED;
            PG8_LDB(B0, 1, 0); PG8_LDB(B1, 1, 1); PG8_SCHED; PG8_LDA(At, 1, 0); PG8_STAGE(PG8_SA(0, 1), a2 + hstep, voffA);
            PG8_WAIT_V(8); PG8_WAIT_L(0); PG8_BAR; PG8_MMA(0, 0, At, B0); PG8_MMA(0, 1, At, B1); PG8_BAR; PG8_SCHED;
            PG8_LDA(At, 1, 1); PG8_STAGE(PG8_SB(1, 0), b3, voffB); PG8_STAGE(PG8_SB(1, 1), b3 + hstep, voffB); PG8_STAGE(PG8_SA(1, 0), a3, voffA);
            PG8_WAIT_V(8); PG8_WAIT_L(0); PG8_BAR; PG8_MMA(1, 0, At, B0); PG8_MMA(1, 1, At, B1); PG8_BAR; PG8_SCHED;
            } else {
            PG8_LDB(B0, 0, 0); PG8_SCHED; PG8_LDA(At, 0, 0); PG8_STAGE(PG8_SA(1, 1), a1 + hstep, voffA);
            PG8_WAIT_L(8); PG8_BAR; PG8_WAIT_L(0); PG8_MMA(0, 0, At, B0); PG8_BAR; PG8_SCHED;
            PG8_LDB(B1, 0, 1); PG8_STAGE(PG8_SB(0, 0), b2, voffB);
            PG8_BAR; PG8_WAIT_L(0); PG8_MMA(0, 1, At, B1); PG8_BAR;
            PG8_LDA(At, 0, 1); PG8_STAGE(PG8_SA(0, 0), a2, voffA);
            PG8_BAR; PG8_WAIT_L(0); PG8_MMA(1, 0, At, B0); PG8_BAR; PG8_SCHED;
            PG8_STAGE(PG8_SB(0, 1), b2 + hstep, voffB);
            PG8_WAIT_V(6); PG8_BAR; PG8_MMA(1, 1, At, B1); PG8_BAR;
            PG8_LDB(B0, 1, 0); PG8_SCHED; PG8_LDA(At, 1, 0); PG8_STAGE(PG8_SA(0, 1), a2 + hstep, voffA);
            PG8_WAIT_L(8); PG8_BAR; PG8_WAIT_L(0); PG8_MMA(0, 0, At, B0); PG8_BAR; PG8_SCHED;
            PG8_LDB(B1, 1, 1); PG8_STAGE(PG8_SB(1, 0), b3, voffB);
            PG8_BAR; PG8_WAIT_L(0); PG8_MMA(0, 1, At, B1); PG8_BAR;
            PG8_LDA(At, 1, 1); PG8_STAGE(PG8_SA(1, 0), a3, voffA);
            PG8_BAR; PG8_WAIT_L(0); PG8_MMA(1, 0, At, B0); PG8_BAR; PG8_SCHED;
            PG8_STAGE(PG8_SB(1, 1), b3 + hstep, voffB);
            PG8_WAIT_V(6); PG8_BAR; PG8_MMA(1, 1, At, B1); PG8_BAR;
            }
        }
        if constexpr (ALIGN_EPI) { if (wr == 0) PG8_BAR; }
        { int l2 = lane; asm volatile("" : "+v"(l2)); E(acc, cur, wr, wc, l2 & 15, l2 >> 4); }
        if (!has_next) break;
        if (!E.keep(cur)) {
#pragma unroll
        for (int a = 0; a < 2; ++a)
#pragma unroll
            for (int b = 0; b < 2; ++b)
#pragma unroll
                for (int m = 0; m < 4; ++m)
#pragma unroll
                    for (int n = 0; n < 2; ++n) acc[a][b][m][n] = (f32x4){0.f, 0.f, 0.f, 0.f};
        }
        cur = nxt; cA = nA; cB = nB; ++ui;
        if constexpr (ALIGN_EPI) { if (wr == 1) PG8_BAR; }
    }
    PG8_WAIT_V(0);
    if constexpr (!ALIGN_EPI) { if (wr == 0) PG8_BAR; }
    PG8_BAR;
#undef PG8_SA
#undef PG8_SB
#undef PG8_STAGE
#undef PG8_LDA
#undef PG8_LDB
#undef PG8_MMA
#undef PG8_WAIT_V
#undef PG8_WAIT_L
#undef PG8_BAR
#undef PG8_SCHED
}}

constexpr int NB = 2, SEQ = 8192, DM = 1024, MT = NB * SEQ, NH = 16, HD = 64, FF = 4096, PLE = 256, NIN = 7168, NMAIN = 4096, NGATE = 2048;
constexpr float EPS = 1e-6f, LOG2E = 1.4426950408889634f, LN2 = 0.6931471805599453f;
constexpr int NWAVES = 8, NPHASE = 10;
constexpr int LDS_BYTES = 151552;

constexpr size_t MiB = 1u << 20;
constexpr size_t WS_KMAX = 0, WS_AGG = 1 * MiB, WS_SS1 = 2 * MiB, WS_SS2 = 3 * MiB, WS_SS3 = 4 * MiB, WS_WGF = 5 * MiB, WS_BAR = 6 * MiB, BAR_BYTES = 16384;
constexpr size_t WS_WIN = 8 * MiB, WS_WBRL = 22 * MiB, WS_WBRA = 24 * MiB, WS_WOUT = 26 * MiB, WS_WUP = 28 * MiB, WS_WDN = 36 * MiB, WS_WPG = 44 * MiB, WS_WPLE = 46 * MiB;
constexpr size_t WS_PB = 48 * MiB;
constexpr size_t WS_XN8 = 24 * MiB, WS_WG8 = 40 * MiB;
constexpr size_t WS_XN = 56 * MiB;
constexpr size_t WS_UX = 88 * MiB;
constexpr size_t WS_UG = 120 * MiB;
constexpr size_t WS_Q = 152 * MiB;
constexpr size_t WS_K = 184 * MiB;
constexpr size_t WS_VT = 216 * MiB;
constexpr size_t WS_END = 248 * MiB;

#define LAS __attribute__((address_space(3)))
typedef unsigned short bf16_t;
typedef short bf16x8 __attribute__((ext_vector_type(8)));
typedef float f32x4 __attribute__((ext_vector_type(4)));
typedef float f32x16 __attribute__((ext_vector_type(16)));
typedef unsigned u32x4 __attribute__((ext_vector_type(4)));
typedef unsigned u32x2 __attribute__((ext_vector_type(2)));
typedef float f32x2_t __attribute__((ext_vector_type(2)));
typedef __bf16 bf16x2_t __attribute__((ext_vector_type(2)));

__device__ __forceinline__ unsigned cvt_pk(float lo, float hi) { f32x2_t v = {lo, hi}; bf16x2_t b = __builtin_convertvector(v, bf16x2_t); return __builtin_bit_cast(unsigned, b); }
__device__ __forceinline__ float bflo(unsigned w) { return __builtin_bit_cast(float, w << 16); }
__device__ __forceinline__ float bfhi(unsigned w) { return __builtin_bit_cast(float, w & 0xffff0000u); }
__device__ __forceinline__ float fsigmoid(float v) { return __builtin_amdgcn_rcpf(1.f + __builtin_amdgcn_exp2f(-LOG2E * v)); }
__device__ __forceinline__ float gelu_tanh(float v) { const float y = 1.5957691216057308f * (v + 0.044715f * v * v * v); return v * fsigmoid(y); }
__device__ __forceinline__ u32x4 pack8(f32x4 a, f32x4 b) { u32x4 w; w.x = cvt_pk(a[0], a[1]); w.y = cvt_pk(a[2], a[3]); w.z = cvt_pk(b[0], b[1]); w.w = cvt_pk(b[2], b[3]); return w; }
__device__ __forceinline__ float wave_sum(float v) {
#pragma unroll
    for (int o = 1; o < 64; o <<= 1) v += __shfl_xor(v, o);
    return v;
}
__device__ __forceinline__ float row_rstd(const float* ss, int row) {
    const f32x4* p = (const f32x4*)(ss + (size_t)row * 16); const f32x4 a = p[0], b = p[1], c = p[2], d = p[3];
    const float s = (((a[0] + a[1]) + (a[2] + a[3])) + ((b[0] + b[1]) + (b[2] + b[3]))) + (((c[0] + c[1]) + (c[2] + c[3])) + ((d[0] + d[1]) + (d[2] + d[3])));
    return __builtin_amdgcn_rsqf(s * (1.f / DM) + EPS);
}
__device__ __forceinline__ int crow(int r, int hi) { return (r & 3) + 8 * (r >> 2) + 4 * hi; }


#define GAS __attribute__((address_space(1)))
#define RLX_AGENT __ATOMIC_RELAXED, __HIP_MEMORY_SCOPE_AGENT
#define XB_TMO      128
#define XB_XCNT(j)  (256  + 64 * (j))
#define XB_XSUB(j)  (1280 + 64 * (j))
#define XB_XGEN(j)  (2304 + 64 * (j))
#define XB_TOP      3328
#define XB_TOPGEN   3392
#define XCD_BAR_WORDS 3456
#define XB_SPIN_CAP (1u << 18)

__device__ __forceinline__ unsigned xb_ld(unsigned* p)              { return __hip_atomic_load(p, __ATOMIC_RELAXED, __HIP_MEMORY_SCOPE_AGENT); }
__device__ __forceinline__ unsigned xb_add(unsigned* p, unsigned v) { return __hip_atomic_fetch_add(p, v, __ATOMIC_RELAXED, __HIP_MEMORY_SCOPE_AGENT); }
__device__ __forceinline__ unsigned xb_xcc_id() { return (unsigned)__builtin_amdgcn_s_getreg((3 << 11) | 20) & 0xFu; }
#define XB_SPIN(cond, bar) do { unsigned _sp = 0; while (cond) { __builtin_amdgcn_s_sleep(1); \
    if ((++_sp & 255u) == 0u) { if (xb_ld(&(bar)[XB_TMO])) break; if (_sp > XB_SPIN_CAP) { atomicAdd(&(bar)[XB_TMO], 1u); break; } } } } while (0)

struct XcdBarrier {
    unsigned* bar; unsigned x;
    volatile LAS unsigned* st;
};

__device__ __forceinline__ XcdBarrier xcd_barrier_post(unsigned* bar, volatile LAS unsigned* st) {
    XcdBarrier b; b.bar = bar; b.x = xb_xcc_id(); b.st = st;
    if (threadIdx.x == 0) (void)xb_add(&bar[XB_XCNT(b.x)], 1u);
    return b;
}
__device__ __forceinline__ void xcd_barrier_complete(unsigned* bar, unsigned x, unsigned& nloc, unsigned& nx) {
    const unsigned G = gridDim.x * gridDim.y * gridDim.z;
    unsigned sum, cnt, mine, sp = 0u;
    for (;;) {
        sum = 0u; cnt = 0u; mine = 0u;
#pragma unroll
        for (unsigned j = 0; j < 16; ++j) { const unsigned c = xb_ld(&bar[XB_XCNT(j)]); sum += c; cnt += (c > 0u) ? 1u : 0u; mine = (j == x) ? c : mine; }
        if (sum == G) break;
        __builtin_amdgcn_s_sleep(1);
        if ((++sp & 255u) == 0u) { if (xb_ld(&bar[XB_TMO])) break; if (sp > XB_SPIN_CAP) { atomicAdd(&bar[XB_TMO], 1u); break; } }
    }
    nloc = mine > 0u ? mine : 1u; nx = cnt > 0u ? cnt : 1u;
}

__device__ __forceinline__ void xcd_barrier(const XcdBarrier& b) {
    asm volatile("s_waitcnt vmcnt(0)" ::: "memory");
    __syncthreads();
    if (threadIdx.x == 0) {
        unsigned* bar = b.bar;
        __builtin_amdgcn_s_waitcnt(0);
        unsigned nloc = b.st[0], nx = b.st[1];
        if (nloc == 0u) { xcd_barrier_complete(bar, b.x, nloc, nx); b.st[0] = nloc; b.st[1] = nx; }
        const unsigned old = xb_add(&bar[XB_XSUB(b.x)], 1u);
        const unsigned gen = old / nloc;
        if (old + 1u == (gen + 1u) * nloc) {
            __builtin_amdgcn_fence(__ATOMIC_RELEASE, "agent");
            asm volatile("s_waitcnt vmcnt(0)" ::: "memory");
            const unsigned og = xb_add(&bar[XB_TOP], 1u);
            const unsigned tg = og / nx;
            if (og + 1u == (tg + 1u) * nx) xb_add(&bar[XB_TOPGEN], 1u);
            else XB_SPIN(xb_ld(&bar[XB_TOPGEN]) == tg, bar);
            __builtin_amdgcn_fence(__ATOMIC_ACQUIRE, "agent");
            xb_add(&bar[XB_XGEN(b.x)], 1u);
            asm volatile("s_waitcnt vmcnt(0)" ::: "memory");
        } else {
            XB_SPIN(xb_ld(&bar[XB_XGEN(b.x)]) == gen, bar);
            __builtin_amdgcn_fence(__ATOMIC_ACQUIRE, "agent");
            asm volatile("s_waitcnt vmcnt(0)" ::: "memory");
        }
    }
    __syncthreads();
}
#define EPI_ARGS const f32x4 (&acc)[2][2][4][2], const pg8::Unit& u, int wr, int wc, int fr, int fq

struct EpiIn {
    static constexpr bool PERM = true;
    __device__ __forceinline__ bool keep(const pg8::Unit&) const { return false; }
    bf16_t *UX, *UG, *Q, *K, *GL, *GA, *VT;
    __device__ __forceinline__ void operator()(EPI_ARGS) const {
        const int row0 = u.pm * 256 + wr * 64 + fr, colt = u.pn * 256 + wc * 32 + 8 * fq;
        if (u.kind == 1) {
#pragma unroll
            for (int ai = 0; ai < 2; ++ai)
#pragma unroll
                for (int m = 0; m < 4; ++m) { bf16_t* rowp = VT + (size_t)(row0 + ai * 128 + m * 16) * MT + colt;
#pragma unroll
                    for (int bj = 0; bj < 2; ++bj) { const u32x4 w = pack8(acc[ai][bj][m][0], acc[ai][bj][m][1]);
                        bf16_t* g16 = rowp + bj * 128 - (fq & 1) * 8;
                        u32x2 lo2 = {w.x, w.y}, hi2 = {w.z, w.w};
                        *(u32x2*)(g16 + ((fq & 1) ? 4 : 0)) = lo2; *(u32x2*)(g16 + ((fq & 1) ? 12 : 8)) = hi2; } }
            return;
        }
        const int sec = u.pn >> 2, cs = colt - sec * 1024;
        bf16_t* base = sec == 0 ? UX : sec == 1 ? UG : sec == 2 ? Q : sec == 3 ? K : sec == 4 ? GL : GA;
#pragma unroll
        for (int ai = 0; ai < 2; ++ai)
#pragma unroll
            for (int m = 0; m < 4; ++m) { bf16_t* rowp = base + (size_t)(row0 + ai * 128 + m * 16) * DM + cs;
#pragma unroll
                for (int bj = 0; bj < 2; ++bj) { f32x4 v0 = acc[ai][bj][m][0], v1 = acc[ai][bj][m][1];
                    if (sec == 1) {
#pragma unroll
                        for (int e = 0; e < 4; ++e) { v0[e] = gelu_tanh(v0[e]); v1[e] = gelu_tanh(v1[e]); }
                    } else if (sec == 2) { v0 = v0 * 0.125f; v1 = v1 * 0.125f; }
                    else if (sec >= 4) {
#pragma unroll
                        for (int e = 0; e < 4; ++e) { v0[e] = fsigmoid(v0[e]); v1[e] = fsigmoid(v1[e]); }
                    }
                    const u32x4 w = pack8(v0, v1);
                    *(u32x4*)(rowp + bj * 128) = w;
} }
    }
};

struct EpiGate {
    static constexpr bool PERM = true;
    __device__ __forceinline__ bool keep(const pg8::Unit&) const { return false; }
    bf16_t *GL, *GA;
    __device__ __forceinline__ void operator()(EPI_ARGS) const {
        const int row0 = u.pm * 256 + wr * 64 + fr, colt = u.pn * 256 + wc * 32 + 8 * fq, sec = u.pn >> 2, cs = colt - sec * 1024;
        bf16_t* base = sec ? GA : GL;
#pragma unroll
        for (int ai = 0; ai < 2; ++ai)
#pragma unroll
            for (int m = 0; m < 4; ++m) { bf16_t* rowp = base + (size_t)(row0 + ai * 128 + m * 16) * DM + cs;
#pragma unroll
                for (int bj = 0; bj < 2; ++bj) { f32x4 v0 = acc[ai][bj][m][0] * 0.03125f, v1 = acc[ai][bj][m][1] * 0.03125f;
#pragma unroll
                    for (int e = 0; e < 4; ++e) { v0[e] = fsigmoid(v0[e]); v1[e] = fsigmoid(v1[e]); }
                    *(u32x4*)(rowp + bj * 128) = pack8(v0, v1); } }
    }
};

struct EpiBr {
    static constexpr bool PERM = true;
    bf16_t* MG; const bf16_t* GL; const bf16_t* GA;
    __device__ __forceinline__ bool keep(const pg8::Unit& u) const { return u.kind == 0; }
    __device__ __forceinline__ void operator()(f32x4 (&acc)[2][2][4][2], const pg8::Unit& u, int wr, int wc, int fr, int fq) const {
        const int row0 = u.pm * 256 + wr * 64 + fr, colt = u.pn * 256 + wc * 32 + 8 * fq;
#pragma unroll
        for (int ai = 0; ai < 2; ++ai)
#pragma unroll
            for (int m = 0; m < 4; ++m) { const size_t ro = (size_t)(row0 + ai * 128 + m * 16) * DM + colt;
#pragma unroll
                for (int bj = 0; bj < 2; ++bj) { const size_t o = ro + bj * 128;
                    const u32x4 ga = *(const u32x4*)(GA + o);
                    float a8[8] = {bflo(ga.x), bfhi(ga.x), bflo(ga.y), bfhi(ga.y), bflo(ga.z), bfhi(ga.z), bflo(ga.w), bfhi(ga.w)};
#pragma unroll
                    for (int e = 0; e < 8; ++e) a8[e] = fmaxf(a8[e], 1e-30f);
                    if (u.kind == 0) { const u32x4 gl = *(const u32x4*)(GL + o);
                        const float l8[8] = {bflo(gl.x), bfhi(gl.x), bflo(gl.y), bfhi(gl.y), bflo(gl.z), bfhi(gl.z), bflo(gl.w), bfhi(gl.w)};
#pragma unroll
                        for (int e = 0; e < 4; ++e) { acc[ai][bj][m][0][e] *= l8[e] * __builtin_amdgcn_rcpf(a8[e]); acc[ai][bj][m][1][e] *= l8[4 + e] * __builtin_amdgcn_rcpf(a8[4 + e]); }
                    } else { f32x4 v0 = acc[ai][bj][m][0], v1 = acc[ai][bj][m][1];
#pragma unroll
                        for (int e = 0; e < 4; ++e) { v0[e] *= a8[e]; v1[e] *= a8[4 + e]; }
                        *(u32x4*)(MG + o) = pack8(v0, v1); } } }
    }
};

template <bool IN_BF16>
struct EpiRes {
    static constexpr bool PERM = true;
    __device__ __forceinline__ bool keep(const pg8::Unit&) const { return false; }
    const void* xin; bf16_t* xb; float* ss;
    __device__ __forceinline__ void operator()(EPI_ARGS) const {
        const int row0 = u.pm * 256 + wr * 64 + fr, colt = u.pn * 256 + wc * 32 + 8 * fq;
#pragma unroll
        for (int ai = 0; ai < 2; ++ai)
#pragma unroll
            for (int m = 0; m < 4; ++m) { const int row = row0 + ai * 128 + m * 16; const size_t ro = (size_t)row * DM + colt; float s = 0.f;
#pragma unroll
                for (int bj = 0; bj < 2; ++bj) { const size_t o = ro + bj * 128;
                    f32x4 v0 = acc[ai][bj][m][0], v1 = acc[ai][bj][m][1];
                    if (IN_BF16) { const u32x4 t = *(const u32x4*)((const bf16_t*)xin + o);
                        v0[0] += bflo(t.x); v0[1] += bfhi(t.x); v0[2] += bflo(t.y); v0[3] += bfhi(t.y); v1[0] += bflo(t.z); v1[1] += bfhi(t.z); v1[2] += bflo(t.w); v1[3] += bfhi(t.w);
                    } else { v0 = v0 + *(const f32x4*)((const float*)xin + o); v1 = v1 + *(const f32x4*)((const float*)xin + o + 4); }
                    *(u32x4*)(xb + o) = pack8(v0, v1);
                    s += ((v0[0] * v0[0] + v0[1] * v0[1]) + (v0[2] * v0[2] + v0[3] * v0[3])) + ((v1[0] * v1[0] + v1[1] * v1[1]) + (v1[2] * v1[2] + v1[3] * v1[3])); }
                s += __shfl_xor(s, 16); s += __shfl_xor(s, 32);
                if (fq == 0) ss[(size_t)row * 16 + u.pn * 4 + wc] = s; }
    }
};

struct EpiUp {
    static constexpr bool PERM = true;
    __device__ __forceinline__ bool keep(const pg8::Unit&) const { return false; }
    bf16_t* H; const float* ss;
    __device__ __forceinline__ void operator()(EPI_ARGS) const {
        const int row0 = u.pm * 256 + wr * 64 + fr, colt = u.pn * 256 + wc * 32 + 8 * fq;
#pragma unroll
        for (int ai = 0; ai < 2; ++ai)
#pragma unroll
            for (int m = 0; m < 4; ++m) { const int row = row0 + ai * 128 + m * 16; const float rs = row_rstd(ss, row); bf16_t* rowp = H + (size_t)row * FF + colt;
#pragma unroll
                for (int bj = 0; bj < 2; ++bj) { f32x4 v0 = acc[ai][bj][m][0] * rs, v1 = acc[ai][bj][m][1] * rs;
#pragma unroll
                    for (int e = 0; e < 4; ++e) { const float a = fmaxf(v0[e], 0.f), b = fmaxf(v1[e], 0.f); v0[e] = a * a; v1[e] = b * b; }
                    *(u32x4*)(rowp + bj * 128) = pack8(v0, v1); } }
    }
};

struct EpiE {
    static constexpr bool PERM = true;
    __device__ __forceinline__ bool keep(const pg8::Unit&) const { return false; }
    bf16_t* E;
    __device__ __forceinline__ void operator()(EPI_ARGS) const {
        const int row0 = u.pm * 256 + wr * 64 + fr, colt = u.pn * 256 + wc * 32 + 8 * fq;
#pragma unroll
        for (int ai = 0; ai < 2; ++ai)
#pragma unroll
            for (int m = 0; m < 4; ++m) { bf16_t* rowp = E + (size_t)(row0 + ai * 128 + m * 16) * DM + colt;
#pragma unroll
                for (int bj = 0; bj < 2; ++bj) *(u32x4*)(rowp + bj * 128) = pack8(acc[ai][bj][m][0], acc[ai][bj][m][1]); }
    }
};

struct EpiPle {
    static constexpr bool PERM = true;
    __device__ __forceinline__ bool keep(const pg8::Unit&) const { return false; }
    const bf16_t* x2; bf16_t* E; const float* ss_in; float* ss_out;
    __device__ __forceinline__ void operator()(EPI_ARGS) const {
        const int row0 = u.pm * 256 + wr * 64 + fr, colt = u.pn * 256 + wc * 32 + 8 * fq;
#pragma unroll
        for (int ai = 0; ai < 2; ++ai)
#pragma unroll
            for (int m = 0; m < 4; ++m) { const int row = row0 + ai * 128 + m * 16; const float rs = row_rstd(ss_in, row); const size_t ro = (size_t)row * DM + colt; float s = 0.f;
#pragma unroll
                for (int bj = 0; bj < 2; ++bj) { const size_t o = ro + bj * 128;
                    const u32x4 ev = *(const u32x4*)(E + o), xv = *(const u32x4*)(x2 + o);
                    f32x4 g0 = acc[ai][bj][m][0] * rs, g1 = acc[ai][bj][m][1] * rs;
#pragma unroll
                    for (int e = 0; e < 4; ++e) { g0[e] = fsigmoid(g0[e]); g1[e] = fsigmoid(g1[e]); }
                    f32x4 v0, v1;
                    v0[0] = bflo(xv.x) + g0[0] * bflo(ev.x); v0[1] = bfhi(xv.x) + g0[1] * bfhi(ev.x); v0[2] = bflo(xv.y) + g0[2] * bflo(ev.y); v0[3] = bfhi(xv.y) + g0[3] * bfhi(ev.y);
                    v1[0] = bflo(xv.z) + g1[0] * bflo(ev.z); v1[1] = bfhi(xv.z) + g1[1] * bfhi(ev.z); v1[2] = bflo(xv.w) + g1[2] * bflo(ev.w); v1[3] = bfhi(xv.w) + g1[3] * bfhi(ev.w);
                    *(u32x4*)(E + o) = pack8(v0, v1);
                    s += ((v0[0] * v0[0] + v0[1] * v0[1]) + (v0[2] * v0[2] + v0[3] * v0[3])) + ((v1[0] * v1[0] + v1[1] * v1[1]) + (v1[2] * v1[2] + v1[3] * v1[3])); }
                s += __shfl_xor(s, 16); s += __shfl_xor(s, 32);
                if (fq == 0) ss_out[(size_t)row * 16 + u.pn * 4 + wc] = s; __builtin_amdgcn_sched_barrier(0); }
    }
};

__device__ __forceinline__ unsigned pk_fp8x4(float a, float b, float c, float d) { int w = 0; w = __builtin_amdgcn_cvt_pk_fp8_f32(a, b, w, false); w = __builtin_amdgcn_cvt_pk_fp8_f32(c, d, w, true); return (unsigned)w; }
template <bool F8 = false>
__device__ __forceinline__ void p0_transpose_item(const float* W, int K, int N, bf16_t* WT, int k0, int n0, int drow0, const float* gs, LAS float* scr, int lane) {
    float wv[32];
#pragma unroll
    for (int i = 0; i < 32; ++i) wv[i] = W[(size_t)(k0 + 2 * i + (lane >> 5)) * N + n0 + (lane & 31)];
    if (gs) {
#pragma unroll
        for (int i = 0; i < 32; ++i) wv[i] *= gs[k0 + 2 * i + (lane >> 5)]; }
#pragma unroll
    for (int i = 0; i < 32; ++i) scr[(2 * i + (lane >> 5)) * 33 + (lane & 31)] = wv[i];
    asm volatile("s_waitcnt lgkmcnt(0)" ::: "memory");
    const int c = lane & 7;
#pragma unroll
    for (int j = 0; j < 4; ++j) { const int n = (lane >> 3) + 8 * j; const LAS float* s = scr + (8 * c) * 33 + n;
        if (F8) { u32x2 o8; o8.x = pk_fp8x4(32.f * s[0 * 33], 32.f * s[1 * 33], 32.f * s[2 * 33], 32.f * s[3 * 33]); o8.y = pk_fp8x4(32.f * s[4 * 33], 32.f * s[5 * 33], 32.f * s[6 * 33], 32.f * s[7 * 33]);
            *(u32x2*)((unsigned char*)WT + (size_t)(drow0 + n) * K + k0 + 8 * c) = o8; }
        else { u32x4 o; o.x = cvt_pk(s[0 * 33], s[1 * 33]); o.y = cvt_pk(s[2 * 33], s[3 * 33]); o.z = cvt_pk(s[4 * 33], s[5 * 33]); o.w = cvt_pk(s[6 * 33], s[7 * 33]);
            *(u32x4*)(WT + (size_t)(drow0 + n) * K + k0 + 8 * c) = o; } }
    asm volatile("s_waitcnt lgkmcnt(0)" ::: "memory");
}

struct Ptrs {
    const float *x, *p, *g_mix, *w_in, *conv_w, *conv_b, *w_rg, *b_rg, *w_ig, *b_ig, *lam, *w_brl, *w_bra, *w_out, *g_mlp, *w_up, *w_dn, *g_ple, *w_pg, *w_ple, *g_fin;
    float* out; unsigned char* ws;
};

template <int PART>
__device__ __forceinline__ void phase0(const Ptrs& P, LAS float* scr, int gw, int NGW, int lane) {
    unsigned char* ws = P.ws;
    constexpr int I_IN = (DM / 64) * (NIN / 32), I_SQ = (DM / 64) * (DM / 32), I_UP = (DM / 64) * (FF / 32), I_DN = (FF / 64) * (DM / 32), I_PLE = (PLE / 64) * (DM / 32);
    constexpr int NITEMS = PART == 0 ? I_IN : 4 * I_SQ + I_UP + I_DN + I_PLE;
    for (int it = gw; it < NITEMS; it += NGW) {
        int r = PART == 0 ? it : it + I_IN;
        if (r < I_IN) { const int nblk = NIN / 32, kb = r / nblk, nb = r % nblk, n0 = 32 * nb, sec = n0 >> 10;
            if (sec < 5) p0_transpose_item(P.w_in, DM, NIN, (bf16_t*)(ws + WS_WIN), 64 * kb, n0, n0, nullptr, scr, lane);
            else p0_transpose_item<true>(P.w_in, DM, NIN, (bf16_t*)(ws + WS_WG8), 64 * kb, n0, n0 - 5120, nullptr, scr, lane);
            continue; } r -= I_IN;
        if (r < I_SQ) { const int nblk = DM / 32; p0_transpose_item(P.w_brl, DM, DM, (bf16_t*)(ws + WS_WBRL), 64 * (r / nblk), 32 * (r % nblk), 32 * (r % nblk), nullptr, scr, lane); continue; } r -= I_SQ;
        if (r < I_SQ) { const int nblk = DM / 32; p0_transpose_item(P.w_bra, DM, DM, (bf16_t*)(ws + WS_WBRA), 64 * (r / nblk), 32 * (r % nblk), 32 * (r % nblk), nullptr, scr, lane); continue; } r -= I_SQ;
        if (r < I_SQ) { const int nblk = DM / 32; p0_transpose_item(P.w_out, DM, DM, (bf16_t*)(ws + WS_WOUT), 64 * (r / nblk), 32 * (r % nblk), 32 * (r % nblk), nullptr, scr, lane); continue; } r -= I_SQ;
        if (r < I_SQ) { const int nblk = DM / 32; p0_transpose_item(P.w_pg, DM, DM, (bf16_t*)(ws + WS_WPG), 64 * (r / nblk), 32 * (r % nblk), 32 * (r % nblk), P.g_ple, scr, lane); continue; } r -= I_SQ;
        if (r < I_UP) { const int nblk = FF / 32; p0_transpose_item(P.w_up, DM, FF, (bf16_t*)(ws + WS_WUP), 64 * (r / nblk), 32 * (r % nblk), 32 * (r % nblk), P.g_mlp, scr, lane); continue; } r -= I_UP;
        if (r < I_DN) { const int nblk = DM / 32; p0_transpose_item(P.w_dn, FF, DM, (bf16_t*)(ws + WS_WDN), 64 * (r / nblk), 32 * (r % nblk), 32 * (r % nblk), nullptr, scr, lane); continue; } r -= I_DN;
        { const int nblk = DM / 32; p0_transpose_item(P.w_ple, PLE, DM, (bf16_t*)(ws + WS_WPLE), 64 * (r / nblk), 32 * (r % nblk), 32 * (r % nblk), nullptr, scr, lane); }
    }
    bf16_t* XN = (bf16_t*)(ws + WS_XN);
    if (PART == 0)
    for (int m = gw; m < MT; m += NGW) {
        const f32x4* xr = (const f32x4*)(P.x + (size_t)m * DM) + lane; const f32x4* gr = (const f32x4*)P.g_mix + lane;
        f32x4 v[4]; float s = 0.f;
#pragma unroll
        for (int j = 0; j < 4; ++j) { v[j] = xr[64 * j]; s += (v[j][0] * v[j][0] + v[j][1] * v[j][1]) + (v[j][2] * v[j][2] + v[j][3] * v[j][3]); }
        const float rstd = __builtin_amdgcn_rsqf(wave_sum(s) * (1.f / DM) + EPS);
        u32x2* o8 = (u32x2*)(XN + (size_t)m * DM) + lane; unsigned* q8 = (unsigned*)(ws + WS_XN8 + (size_t)m * DM) + lane;
#pragma unroll
        for (int j = 0; j < 4; ++j) { const f32x4 g = gr[64 * j]; const float h0 = v[j][0] * rstd * g[0], h1 = v[j][1] * rstd * g[1], h2 = v[j][2] * rstd * g[2], h3 = v[j][3] * rstd * g[3];
            u32x2 o; o.x = cvt_pk(h0, h1); o.y = cvt_pk(h2, h3); o8[64 * j] = o; q8[64 * j] = pk_fp8x4(h0, h1, h2, h3); }
    }
    if (PART == 1) { bf16_t* PB = (bf16_t*)(ws + WS_PB); const int ngrp = MT * PLE / 8;
#pragma unroll 4
        for (int gidx = gw * 64 + lane; gidx < ngrp; gidx += NGW * 64) { const f32x4 a = *(const f32x4*)(P.p + (size_t)gidx * 8), b = *(const f32x4*)(P.p + (size_t)gidx * 8 + 4); *(u32x4*)(PB + (size_t)gidx * 8) = pack8(a, b); } }
    if (PART == 0) { bf16_t* WGF = (bf16_t*)(ws + WS_WGF);
        for (int f = gw; f < 256; f += NGW) { const int kk = f & 3, cbh = (f >> 2) & 1, gate = (f >> 3) & 1, n = f >> 4;
            const float* w = (gate ? P.w_ig : P.w_rg) + (size_t)n * 4096 + (size_t)(16 * kk + 8 * (lane >> 5)) * 64 + 32 * cbh + (lane & 31);
            u32x4 o; o.x = cvt_pk(w[0], w[64]); o.y = cvt_pk(w[128], w[192]); o.z = cvt_pk(w[256], w[320]); o.w = cvt_pk(w[384], w[448]);
            *(u32x4*)(WGF + ((size_t)f * 64 + lane) * 8) = o; } }
}

template <bool PASS_B>
__device__ __forceinline__ void lru_unit(const Ptrs& P, LAS unsigned char* wlds  , int wu, int lane) {
    unsigned char* ws = P.ws;
    const bf16_t* UX = (const bf16_t*)(ws + WS_UX); bf16_t* UG = (bf16_t*)(ws + WS_UG); bf16_t* YL = (bf16_t*)(ws + WS_XN);
    float* AGG = (float*)(ws + WS_AGG); const bf16_t* WGF = (const bf16_t*)(ws + WS_WGF);
    const int n = wu & 15, chunk = (wu >> 4) & 63, b = wu >> 10, r32 = lane & 31, hh = lane >> 5;
    const size_t tokbase = (size_t)b * SEQ;
    float st[2], atot[2], cbr[2], cbi[2], csp[2];
#pragma unroll
    for (int cbh = 0; cbh < 2; ++cbh) { const int ch = 64 * n + 32 * cbh + r32;
        cbr[cbh] = P.b_rg[ch]; cbi[cbh] = P.b_ig[ch];
        const float l = P.lam[ch]; csp[cbh] = 8.f * LOG2E * (fmaxf(-l, 0.f) + log1pf(expf(-fabsf(l))));
        atot[cbh] = 1.f; float s = 0.f;
        st[cbh] = s; }
    u32x4 xn[16];
#define LRU_LOADX(TOK) do { _Pragma("unroll") for (int kk = 0; kk < 4; ++kk) { const int ch0 = 64 * n + 16 * kk + 8 * hh; _Pragma("unroll") for (int k = 0; k < 4; ++k) { const int tt = (TOK) - 3 + k; \
        u32x4 xv = {0u, 0u, 0u, 0u}; if (tt >= 0) xv = *(const u32x4*)(UX + (tokbase + tt) * DM + ch0); xn[kk * 4 + k] = xv; } } } while (0)
#define LRU_CONV() do { _Pragma("unroll") for (int kk = 0; kk < 4; ++kk) { const int ch0 = 64 * n + 16 * kk + 8 * hh; \
        f32x4 c0 = *(const f32x4*)(cbp + ch0), c1 = *(const f32x4*)(cbp + ch0 + 4); \
        _Pragma("unroll") for (int k = 0; k < 4; ++k) { const u32x4 xv = xn[kk * 4 + k]; \
            const f32x4 w0 = *(const f32x4*)(cwp + k * DM + ch0), w1 = *(const f32x4*)(cwp + k * DM + ch0 + 4); \
            c0[0] += w0[0] * bflo(xv.x); c0[1] += w0[1] * bfhi(xv.x); c0[2] += w0[2] * bflo(xv.y); c0[3] += w0[3] * bfhi(xv.y); \
            c1[0] += w1[0] * bflo(xv.z); c1[1] += w1[1] * bfhi(xv.z); c1[2] += w1[2] * bflo(xv.w); c1[3] += w1[3] * bfhi(xv.w); } \
        af[kk] = __builtin_bit_cast(bf16x8, pack8(c0, c1)); } } while (0)
    bf16x8 af[4];
    { const float* cwp = P.conv_w; const float* cbp = P.conv_b; LRU_LOADX(chunk * 128 + r32); LRU_CONV(); }
#pragma unroll 1
    for (int sb = 0; sb < 4; ++sb) {
        const int t0s = chunk * 128 + sb * 32;
        const float* cwp = P.conv_w; const float* cbp = P.conv_b; const bf16_t* wgf = WGF; int hl = hh;
        asm volatile("" : "+s"(cwp), "+s"(cbp), "+s"(wgf), "+v"(hl));
#pragma unroll 1
        for (int cbh = 0; cbh < 2; ++cbh) {
            const int col = 32 * cbh + r32, ch = 64 * n + col;
            const float k_br = cbh ? cbr[1] : cbr[0], k_bi = cbh ? cbi[1] : cbi[0], k_sp = cbh ? csp[1] : csp[0];
            bf16x8 wbr[4], wbi[4];
#pragma unroll
            for (int kk = 0; kk < 4; ++kk) { wbr[kk] = *(const bf16x8*)(wgf + ((size_t)((((n * 2 + 0) * 2 + cbh) * 4 + kk) * 64) + lane) * 8);
                wbi[kk] = *(const bf16x8*)(wgf + ((size_t)((((n * 2 + 1) * 2 + cbh) * 4 + kk) * 64) + lane) * 8); }
            f32x16 dr, di, dc;
#pragma unroll
            for (int e = 0; e < 16; ++e) { dr[e] = 0.f; di[e] = 0.f; dc[e] = 0.f; }
#pragma unroll
            for (int kk = 0; kk < 4; ++kk) {
                u32x4 idv = {0u, 0u, 0u, 0u};
                if ((col >> 3) == 2 * kk + hl) { const unsigned one = (col & 1) ? 0x3F800000u : 0x00003F80u; const int pi = (col & 7) >> 1;
                    idv.x = pi == 0 ? one : 0u; idv.y = pi == 1 ? one : 0u; idv.z = pi == 2 ? one : 0u; idv.w = pi == 3 ? one : 0u; }
                dr = __builtin_amdgcn_mfma_f32_32x32x16_bf16(af[kk], wbr[kk], dr, 0, 0, 0);
                di = __builtin_amdgcn_mfma_f32_32x32x16_bf16(af[kk], wbi[kk], di, 0, 0, 0);
                dc = __builtin_amdgcn_mfma_f32_32x32x16_bf16(af[kk], __builtin_bit_cast(bf16x8, idv), dc, 0, 0, 0);
            }
            __builtin_amdgcn_sched_barrier(0);
#pragma unroll
            for (int k2 = 0; k2 < 2; ++k2)
#pragma unroll
                for (int k = 0; k < 4; ++k) { const int kk = 2 * cbh + k2;
                    __builtin_amdgcn_global_load_lds((const unsigned*)(UX + (tokbase + t0s + 32 + r32 - 3 + k) * DM + 64 * n + 16 * kk + 8 * hh), (LAS unsigned*)(wlds + (kk * 4 + k) * 1024), 16, 0, 0); }
            __builtin_amdgcn_sched_barrier(0);
            float a[16], uu[16];
#pragma unroll
            for (int r = 0; r < 16; ++r) { const float rg = fsigmoid(dr[r] + k_br), di1 = 1.f + __builtin_amdgcn_exp2f(-LOG2E * (di[r] + k_bi));
                const float av = __builtin_amdgcn_exp2f(-k_sp * rg);
                const float y = fmaxf(1.f - av * av, 1e-30f);
                a[r] = av; uu[r] = (y * __builtin_amdgcn_rsqf(y * di1 * di1)) * dc[r]; }
            __builtin_amdgcn_sched_barrier(0);
            bf16_t* ugb = UG + (tokbase + t0s) * DM + 64 * n; bf16_t* ylb = YL + (tokbase + t0s) * DM + 64 * n;
            unsigned lofs = (unsigned)(4 * hh * DM + 32 * cbh + r32); asm volatile("" : "+v"(lofs));
            unsigned ugv[16];
            if (PASS_B) {
#pragma unroll
                for (int r = 0; r < 16; ++r) ugv[r] = (unsigned)ugb[lofs + (unsigned)(((r & 3) + 8 * (r >> 2)) * DM)];
            }
            __builtin_amdgcn_sched_barrier(0);
            float Ag[4], Hg[4], pA[4], pH[4], cin[4], pin[4];
#pragma unroll
            for (int g = 0; g < 4; ++g) { Ag[g] = (a[4 * g] * a[4 * g + 1]) * (a[4 * g + 2] * a[4 * g + 3]);
                Hg[g] = ((uu[4 * g] * a[4 * g + 1] + uu[4 * g + 1]) * a[4 * g + 2] + uu[4 * g + 2]) * a[4 * g + 3] + uu[4 * g + 3]; }
#pragma unroll
            for (int g = 0; g < 4; ++g) { pA[g] = __shfl_xor(Ag[g], 32); pH[g] = __shfl_xor(Hg[g], 32); }
            float run = cbh ? st[1] : st[0], ap = cbh ? atot[1] : atot[0];
#pragma unroll
            for (int g = 0; g < 4; ++g) { const float A0 = hh ? pA[g] : Ag[g], H0 = hh ? pH[g] : Hg[g], A1 = hh ? Ag[g] : pA[g], H1 = hh ? Hg[g] : pH[g];
                const float c0 = run; run = A0 * run + H0; const float c1 = run; run = A1 * run + H1; cin[g] = hh ? c1 : c0;
                const float q1 = ap * A0; pin[g] = hh ? q1 : ap; ap = q1 * A1; }
            if (cbh) { st[1] = run; atot[1] = ap; } else { st[0] = run; atot[0] = ap; }
            if (PASS_B) {
#pragma unroll
                for (int g = 0; g < 4; ++g) { float hv = cin[g], pv = pin[g];
#pragma unroll
                    for (int i = 0; i < 4; ++i) { const int r = 4 * g + i; hv = a[r] * hv + uu[r]; pv *= a[r];
                        const unsigned o = lofs + (unsigned)(((r & 3) + 8 * (r >> 2)) * DM); const float ug = bflo(ugv[r]);
                        const unsigned w = cvt_pk(hv * ug, pv * ug);
                        ylb[o] = (bf16_t)(w & 0xffffu); ugb[o] = (bf16_t)(w >> 16); } }
            }
        }
        if (sb < 3) {
            asm volatile("s_waitcnt vmcnt(0)" ::: "memory");
#pragma unroll
            for (int q = 0; q < 16; ++q) xn[q] = *(const LAS u32x4*)(wlds + q * 1024 + lane * 16);
            LRU_CONV(); }
    }
#undef LRU_LOADX
#undef LRU_CONV
    asm volatile("s_waitcnt vmcnt(0)" ::: "memory");
    {
#pragma unroll
        for (int cbh = 0; cbh < 2; ++cbh) { const int ch = 64 * n + 32 * cbh + r32; float* ag = AGG + ((size_t)(b * 64 + chunk) * 2) * DM + ch;
            if (hh == 0) { ag[0] = atot[cbh]; ag[DM] = st[cbh]; } }
    }
}

__device__ __forceinline__ void lru_light(const Ptrs& P, int wu, int lane) {
    unsigned char* ws = P.ws;
    bf16_t* YL = (bf16_t*)(ws + WS_XN); const bf16_t* PU = (const bf16_t*)(ws + WS_UG); const float* AGG = (const float*)(ws + WS_AGG);
    const int n = wu & 15, chunk = (wu >> 4) & 63, b = wu >> 10, ch0 = 64 * n + 8 * (lane & 7);
    if (chunk == 0) return;
    f32x4 s0 = {0.f, 0.f, 0.f, 0.f}, s1 = {0.f, 0.f, 0.f, 0.f};
    for (int c0 = 0; c0 < chunk; c0 += 4) { f32x4 A0[4], A1[4], H0[4], H1[4];
#pragma unroll
        for (int j = 0; j < 4; ++j) { const bool ok = c0 + j < chunk; const float* ag = AGG + ((size_t)(b * 64 + (ok ? c0 + j : 0)) * 2) * DM + ch0;
            A0[j] = *(const f32x4*)ag; A1[j] = *(const f32x4*)(ag + 4); H0[j] = *(const f32x4*)(ag + DM); H1[j] = *(const f32x4*)(ag + DM + 4);
            if (!ok) { A0[j] = (f32x4){1.f, 1.f, 1.f, 1.f}; A1[j] = A0[j]; H0[j] = (f32x4){0.f, 0.f, 0.f, 0.f}; H1[j] = H0[j]; } }
#pragma unroll
        for (int j = 0; j < 4; ++j) { s0 = A0[j] * s0 + H0[j]; s1 = A1[j] * s1 + H1[j]; } }
    const size_t base = ((size_t)b * SEQ + chunk * 128 + (lane >> 3)) * DM + ch0;
#pragma unroll 4
    for (int i = 0; i < 16; ++i) { const size_t o = base + (size_t)(8 * i) * DM;
        const u32x4 y = *(const u32x4*)(YL + o), p = *(const u32x4*)(PU + o);
        f32x4 v0, v1;
        v0[0] = bflo(y.x) + bflo(p.x) * s0[0]; v0[1] = bfhi(y.x) + bfhi(p.x) * s0[1]; v0[2] = bflo(y.y) + bflo(p.y) * s0[2]; v0[3] = bfhi(y.y) + bfhi(p.y) * s0[3];
        v1[0] = bflo(y.z) + bflo(p.z) * s1[0]; v1[1] = bfhi(y.z) + bfhi(p.z) * s1[1]; v1[2] = bflo(y.w) + bflo(p.w) * s1[2]; v1[3] = bfhi(y.w) + bfhi(p.w) * s1[3];
        *(u32x4*)(YL + o) = pack8(v0, v1); }
}

__device__ __forceinline__ void sb_block(const f32x16& z, float (&om)[16], float (&be)[16], int lim) {
#pragma unroll
    for (int r = 0; r < 16; ++r) { const float e = __builtin_amdgcn_exp2f(LOG2E * fminf(z[r], 60.f)), o = __builtin_amdgcn_rcpf(1.f + e);
        const bool ok = ((r & 3) + 8 * (r >> 2)) < lim; om[r] = ok ? o : 1.f; be[r] = ok ? e * o : 0.f; }
}
template <bool DRY>
__device__ __forceinline__ void attn_unit(const Ptrs& P, LAS unsigned char* wlds  , int wu, int lane) {
    unsigned char* ws = P.ws;
    const bf16_t* Kb = (const bf16_t*)(ws + WS_K); const bf16_t* VT = (const bf16_t*)(ws + WS_VT); bf16_t* QO = (bf16_t*)(ws + WS_Q);
    const int qb = wu & 255, h = (wu >> 8) & 15, b = wu >> 12, r32 = lane & 31, hh = lane >> 5, t0 = qb * 32, tq = t0 + r32;
    const size_t rowbase = (size_t)b * SEQ;
    bf16x8 qf[4];
    { const bf16_t* qp = QO + (rowbase + tq) * DM + h * HD + 8 * hh;
#pragma unroll
        for (int kk = 0; kk < 4; ++kk) qf[kk] = *(const bf16x8*)(qp + 16 * kk); }
    f32x16 o0, o1;
#pragma unroll
    for (int e = 0; e < 16; ++e) { o0[e] = 0.f; o1[e] = 0.f; }
    float C2 = 0.f;
    const int lrow = lane >> 3, lch = lane & 7;
    const bf16_t* kg = Kb + (rowbase + lrow) * DM + h * HD + 8 * lch;
    const bf16_t* vg = VT + (size_t)(h * HD + lrow) * MT + rowbase + 8 * lch;
    LAS unsigned char* kl = wlds; LAS unsigned char* vl = wlds + 9216;
    const int wofs = lrow * 144 + lch * 16, rofs = r32 * 144 + hh * 16;
    u32x4 kr[8];
    { const bf16_t* kp = kg + (size_t)((t0 >> 6) * 64) * DM;
#pragma unroll
        for (int i2 = 0; i2 < 8; ++i2) kr[i2] = *(const u32x4*)(kp + (size_t)(8 * i2) * DM); }
    u32x4 vr[8];
#pragma unroll
    for (int i2 = 0; i2 < 8; ++i2) vr[i2] = *(const u32x4*)(vg + (size_t)(8 * i2) * MT + (t0 >> 6) * 64);
#pragma unroll 1
    for (int kt = t0 >> 6; kt >= 0; --kt) {
        const int s0 = kt * 64;
#pragma unroll
        for (int i2 = 0; i2 < 8; ++i2) *(LAS u32x4*)(kl + wofs + i2 * 8 * 144) = kr[i2];
        f32x16 p0, p1;
#pragma unroll
        for (int e = 0; e < 16; ++e) { p0[e] = 0.f; p1[e] = 0.f; }
#pragma unroll
        for (int kk = 0; kk < 4; ++kk) { const bf16x8 k0 = *(const LAS bf16x8*)(kl + rofs + kk * 32), k1 = *(const LAS bf16x8*)(kl + rofs + 32 * 144 + kk * 32);
            p0 = __builtin_amdgcn_mfma_f32_32x32x16_bf16(k0, qf[kk], p0, 0, 0, 0); p1 = __builtin_amdgcn_mfma_f32_32x32x16_bf16(k1, qf[kk], p1, 0, 0, 0); }
        if (kt > 0) { const bf16_t* kp = kg + (size_t)(s0 - 64) * DM;
#pragma unroll
            for (int i2 = 0; i2 < 8; ++i2) kr[i2] = *(const u32x4*)(kp + (size_t)(8 * i2) * DM); }
        float om0[16], om1[16], be0[16], be1[16];
        sb_block(p0, om0, be0, tq - s0 - 4 * hh); sb_block(p1, om1, be1, tq - s0 - 32 - 4 * hh);
        float G0[4], G1[4], Q0[4], Q1[4], off0[4], off1[4];
#pragma unroll
        for (int g = 0; g < 4; ++g) { G0[g] = (om0[4 * g] * om0[4 * g + 1]) * (om0[4 * g + 2] * om0[4 * g + 3]); G1[g] = (om1[4 * g] * om1[4 * g + 1]) * (om1[4 * g + 2] * om1[4 * g + 3]); }
#pragma unroll
        for (int g = 0; g < 4; ++g) { Q0[g] = __shfl_xor(G0[g], 32); Q1[g] = __shfl_xor(G1[g], 32); }
        float run = __builtin_amdgcn_exp2f(C2);
#pragma unroll
        for (int g = 3; g >= 0; --g) { const float hi = hh ? G1[g] : Q1[g], lo = hh ? Q1[g] : G1[g]; const float oh = run; run *= hi; const float ol = run; run *= lo; off1[g] = hh ? oh : ol; }
#pragma unroll
        for (int g = 3; g >= 0; --g) { const float hi = hh ? G0[g] : Q0[g], lo = hh ? Q0[g] : G0[g]; const float oh = run; run *= hi; const float ol = run; run *= lo; off0[g] = hh ? oh : ol; }
#pragma unroll
        for (int g = 3; g >= 0; --g) { float cum = off1[g];
#pragma unroll
            for (int i = 3; i >= 0; --i) { const int r = 4 * g + i; p1[r] = be1[r] * cum; cum *= om1[r]; } }
#pragma unroll
        for (int g = 3; g >= 0; --g) { float cum = off0[g];
#pragma unroll
            for (int i = 3; i >= 0; --i) { const int r = 4 * g + i; p0[r] = be0[r] * cum; cum *= om0[r]; } }
        { float tp = 1.f;
#pragma unroll
            for (int g = 0; g < 4; ++g) tp *= (G0[g] * Q0[g]) * (G1[g] * Q1[g]);
            C2 += __builtin_amdgcn_logf(tp); }
#pragma unroll
        for (int i2 = 0; i2 < 8; ++i2) *(LAS u32x4*)(vl + wofs + i2 * 8 * 144) = vr[i2];
        if (kt > 0) {
#pragma unroll
            for (int i2 = 0; i2 < 8; ++i2) vr[i2] = *(const u32x4*)(vg + (size_t)(8 * i2) * MT + s0 - 64); }
#pragma unroll
        for (int kb = 0; kb < 2; ++kb)
#pragma unroll
            for (int s = 0; s < 2; ++s) { u32x4 pw;
                if (kb == 0) { pw.x = cvt_pk(p0[8 * s], p0[8 * s + 1]); pw.y = cvt_pk(p0[8 * s + 2], p0[8 * s + 3]); pw.z = cvt_pk(p0[8 * s + 4], p0[8 * s + 5]); pw.w = cvt_pk(p0[8 * s + 6], p0[8 * s + 7]); }
                else { pw.x = cvt_pk(p1[8 * s], p1[8 * s + 1]); pw.y = cvt_pk(p1[8 * s + 2], p1[8 * s + 3]); pw.z = cvt_pk(p1[8 * s + 4], p1[8 * s + 5]); pw.w = cvt_pk(p1[8 * s + 6], p1[8 * s + 7]); }
                const bf16x8 pa = __builtin_bit_cast(bf16x8, pw);
                const bf16x8 va = *(const LAS bf16x8*)(vl + rofs + (32 * kb + 16 * s) * 2), vb = *(const LAS bf16x8*)(vl + rofs + 32 * 144 + (32 * kb + 16 * s) * 2);
                o0 = __builtin_amdgcn_mfma_f32_32x32x16_bf16(pa, va, o0, 0, 0, 0);
                o1 = __builtin_amdgcn_mfma_f32_32x32x16_bf16(pa, vb, o1, 0, 0, 0); }
        if (__builtin_amdgcn_ballot_w64(C2 >= -150.f) == 0ull) break;
    }
    if (DRY) { if (C2 != 12345.678f) return; }
    bf16_t* op = QO + (rowbase + t0) * DM + h * HD + r32;
#pragma unroll
    for (int r = 0; r < 16; ++r) { bf16_t* o = op + (size_t)crow(r, hh) * DM; o[0] = (bf16_t)(cvt_pk(o0[r], 0.f) & 0xffffu); o[32] = (bf16_t)(cvt_pk(o1[r], 0.f) & 0xffffu); }
}

struct Args { const float* in[21]; float* out; unsigned char* ws; int ph_lo, ph_hi; };
__global__ void __launch_bounds__(NWAVES * 64, 2) mk_fwd(Args args) {
    extern __shared__ __attribute__((aligned(16))) unsigned char lds_raw[];
    LAS unsigned char* lds = (LAS unsigned char*)lds_raw;
    cg::grid_group grid = cg::this_grid();
    const int G = gridDim.x, bx = blockIdx.x, NGW = G * NWAVES;
#define PHASE_IDS int tid_ = threadIdx.x; asm volatile("" : "+v"(tid_)); const int lane = tid_ & 63, wave = __builtin_amdgcn_readfirstlane(tid_ >> 6), gw = bx * NWAVES + wave; (void)lane; (void)gw;
    Ptrs P;
    P.x = args.in[0]; P.p = args.in[1]; P.g_mix = args.in[2]; P.w_in = args.in[3]; P.conv_w = args.in[4]; P.conv_b = args.in[5]; P.w_rg = args.in[6]; P.b_rg = args.in[7];
    P.w_ig = args.in[8]; P.b_ig = args.in[9]; P.lam = args.in[10]; P.w_brl = args.in[11]; P.w_bra = args.in[12]; P.w_out = args.in[13]; P.g_mlp = args.in[14]; P.w_up = args.in[15];
    P.w_dn = args.in[16]; P.g_ple = args.in[17]; P.w_pg = args.in[18]; P.w_ple = args.in[19]; P.g_fin = args.in[20]; P.out = args.out; P.ws = args.ws;
    unsigned char* ws = args.ws;
    const int lo = args.ph_lo, hi = args.ph_hi;
#ifndef REPMASK
#define REPMASK 0
#endif
#define NREP(k) (((REPMASK >> (k)) & 1) ? 2 : 1)
#ifndef PHMASK
#define PHMASK 0x3ff
#endif
#define IN(k) (((PHMASK >> (k)) & 1) && lo <= (k) && (k) < hi)
    volatile LAS unsigned* MISC = (volatile LAS unsigned*)(lds + 147456);
    if (threadIdx.x < 64) MISC[threadIdx.x] = 0u;
    __syncthreads();
    XcdBarrier bar = xcd_barrier_post((unsigned*)(ws + WS_BAR), MISC + 8);
    if (args.ph_hi > 1000) grid.sync();
#define SEAM(k) do { if (IN(k) && IN((k) + 1)) { xcd_barrier(bar); } } while (0)
    bf16_t* GL = (bf16_t*)P.out; bf16_t* GA = GL + (size_t)MT * DM;

    for (int rep_ = 0; rep_ < NREP(0); ++rep_) { if (rep_) xcd_barrier(bar);
    if (IN(0)) { PHASE_IDS phase0<0>(P, (LAS float*)(lds + wave * 18432), gw, NGW, lane); __syncthreads(); }
    }
    SEAM(0);
    for (int rep_ = 0; rep_ < NREP(1); ++rep_) { if (rep_) xcd_barrier(bar);
    if (IN(1)) {
        { pg8::Sched2 S; S.A0 = (const char*)(ws + WS_XN); S.B0 = (const char*)(ws + WS_WIN); S.nM0 = MT / 256; S.nN0 = NMAIN / 256;
        S.A1 = (const char*)(ws + WS_WIN) + (size_t)NMAIN * DM * 2; S.B1 = (const char*)(ws + WS_XN); S.nM1 = DM / 256; S.nN1 = MT / 256; S.mode = 0; S.G = G; S.c = bx; S.tstep = (size_t)256 * DM * 2;
        EpiIn E{(bf16_t*)(ws + WS_UX), (bf16_t*)(ws + WS_UG), (bf16_t*)(ws + WS_Q), (bf16_t*)(ws + WS_K), GL, GA, (bf16_t*)(ws + WS_VT)};
        pg8::gemm_phase<EpiIn, pg8::Sched2, true, true>(lds, DM, S, E); }
        __syncthreads();
        { pg8::Sched2 S; S.A0 = (const char*)(ws + WS_XN8); S.B0 = (const char*)(ws + WS_WG8); S.nM0 = MT / 256; S.nN0 = NGATE / 256; S.A1 = S.A0; S.B1 = S.B0; S.nM1 = 0; S.nN1 = 0; S.mode = 0; S.G = G; S.c = bx; S.tstep = (size_t)256 * DM;
        EpiGate E{GL, GA};
        pg8::gemm_phase<EpiGate, pg8::Sched2, true, true, true>(lds, DM / 2, S, E); }
    }
    }
    SEAM(1);
    {
    if (IN(2)) { PHASE_IDS
        const bool conv_first = (wave & 4) != 0;
#pragma unroll 1
        for (int step = 0; step < 2; ++step) {
            int l2 = lane; asm volatile("" : "+v"(l2));
            if ((step == 0) == conv_first) phase0<1>(P, (LAS float*)(lds + wave * 18432), gw, NGW, l2);
            else { for (int wu = gw; wu < NB * 64 * 16; wu += NGW) lru_unit<true>(P, lds + wave * 18432, wu, l2); } } }
    }
    SEAM(2);
    if (IN(3)) {
        PHASE_IDS
        const bool attn_first = (wave & 4) != 0;
#pragma unroll 1
        for (int step = 0; step < 2; ++step) {
            if ((step == 0) == attn_first) {
                if ((REPMASK >> 10) & 1) { for (int wu = gw; wu < NB * NH * (SEQ / 32); wu += NGW) attn_unit<true>(P, lds + wave * 18432, wu, lane); }
                for (int wu = gw; wu < NB * NH * (SEQ / 32); wu += NGW) attn_unit<false>(P, lds + wave * 18432, wu, lane);
            } else {
                for (int wu = gw; wu < NB * 64 * 16; wu += NGW) lru_light(P, wu, lane);
            } }
    }
    SEAM(3);
    for (int rep_ = 0; rep_ < NREP(4); ++rep_) { if (rep_) xcd_barrier(bar);
    if (IN(4)) {
        pg8::Sched2 S; S.A0 = (const char*)(ws + WS_XN); S.B0 = (const char*)(ws + WS_WBRL); S.nM0 = MT / 256; S.nN0 = DM / 256;
        S.A1 = (const char*)(ws + WS_Q); S.B1 = (const char*)(ws + WS_WBRA); S.nM1 = MT / 256; S.nN1 = DM / 256; S.mode = 1; S.G = G; S.c = bx; S.tstep = (size_t)256 * DM * 2;
        EpiBr E{(bf16_t*)(ws + WS_UX), GL, GA};
        pg8::gemm_phase<EpiBr, pg8::Sched2, true, true>(lds, DM, S, E);
    }
    }
    SEAM(4);
    for (int rep_ = 0; rep_ < NREP(5); ++rep_) { if (rep_) xcd_barrier(bar);
    if (IN(5)) {
        pg8::Sched2 S; S.A0 = (const char*)(ws + WS_UX); S.B0 = (const char*)(ws + WS_WOUT); S.nM0 = MT / 256; S.nN0 = DM / 256; S.A1 = S.A0; S.B1 = S.B0; S.nM1 = 0; S.nN1 = 0; S.mode = 0; S.G = G; S.c = bx; S.tstep = (size_t)256 * DM * 2;
        EpiRes<false> E{(const void*)P.x, (bf16_t*)(ws + WS_XN), (float*)(ws + WS_SS1)};
        pg8::gemm_phase<EpiRes<false>, pg8::Sched2, true, true>(lds, DM, S, E);
    }
    }
    SEAM(5);
    for (int rep_ = 0; rep_ < NREP(6); ++rep_) { if (rep_) xcd_barrier(bar);
    if (IN(6)) {
        pg8::Sched2 S; S.A0 = (const char*)(ws + WS_XN); S.B0 = (const char*)(ws + WS_WUP); S.nM0 = MT / 256; S.nN0 = FF / 256; S.A1 = S.A0; S.B1 = S.B0; S.nM1 = 0; S.nN1 = 0; S.mode = 0; S.G = G; S.c = bx; S.tstep = (size_t)256 * DM * 2;
        EpiUp E{(bf16_t*)(ws + WS_UG), (const float*)(ws + WS_SS1)};
        pg8::gemm_phase<EpiUp, pg8::Sched2, true, true>(lds, DM, S, E);
    }
    }
    SEAM(6);
    if (IN(7)) {
        pg8::Sched2 S; S.A0 = (const char*)(ws + WS_UG); S.B0 = (const char*)(ws + WS_WDN); S.nM0 = MT / 256; S.nN0 = DM / 256; S.A1 = S.A0; S.B1 = S.B0; S.nM1 = 0; S.nN1 = 0; S.mode = 0; S.G = G; S.c = bx; S.tstep = (size_t)256 * FF * 2;
        EpiRes<true> E{(const void*)(ws + WS_XN), (bf16_t*)(ws + WS_UX), (float*)(ws + WS_SS2)};
        pg8::gemm_phase<EpiRes<true>, pg8::Sched2, true, true>(lds, FF, S, E);
    }
    SEAM(7);
    if (IN(8)) {
        { pg8::Sched2 S; S.A0 = (const char*)(ws + WS_PB); S.B0 = (const char*)(ws + WS_WPLE); S.nM0 = MT / 256; S.nN0 = DM / 256; S.A1 = S.A0; S.B1 = S.B0; S.nM1 = 0; S.nN1 = 0; S.mode = 0; S.G = G; S.c = bx; S.tstep = (size_t)256 * PLE * 2;
            EpiE E{(bf16_t*)(ws + WS_XN)};
            int kple = PLE; asm volatile("" : "+s"(kple));
            pg8::gemm_phase<EpiE, pg8::Sched2, true, true>(lds, kple, S, E); }
        __syncthreads();
        { pg8::Sched2 S; S.A0 = (const char*)(ws + WS_UX); S.B0 = (const char*)(ws + WS_WPG); S.nM0 = MT / 256; S.nN0 = DM / 256; S.A1 = S.A0; S.B1 = S.B0; S.nM1 = 0; S.nN1 = 0; S.mode = 0; S.G = G; S.c = bx; S.tstep = (size_t)256 * DM * 2;
            EpiPle E{(const bf16_t*)(ws + WS_UX), (bf16_t*)(ws + WS_XN), (const float*)(ws + WS_SS2), (float*)(ws + WS_SS3)};
            pg8::gemm_phase<EpiPle, pg8::Sched2, true, true>(lds, DM, S, E); }
    }
    SEAM(8);
    if (IN(9)) {
        PHASE_IDS
        const float* ss = (const float*)(ws + WS_SS3);
        const bf16_t* X3 = (const bf16_t*)(ws + WS_XN);
        for (int m = gw; m < MT; m += NGW) { const float rs = row_rstd(ss, m);
            const u32x4* xr = (const u32x4*)(X3 + (size_t)m * DM) + lane; f32x4* orow = (f32x4*)(P.out + (size_t)m * DM); const f32x4* gr = (const f32x4*)P.g_fin;
#pragma unroll
            for (int j = 0; j < 2; ++j) { const u32x4 w = xr[64 * j]; const int c4 = (64 * j + lane) * 2; const f32x4 ga = gr[c4], gb = gr[c4 + 1];
                f32x4 a, b2; a[0] = bflo(w.x) * rs * ga[0]; a[1] = bfhi(w.x) * rs * ga[1]; a[2] = bflo(w.y) * rs * ga[2]; a[3] = bfhi(w.y) * rs * ga[3];
                b2[0] = bflo(w.z) * rs * gb[0]; b2[1] = bfhi(w.z) * rs * gb[1]; b2[2] = bflo(w.w) * rs * gb[2]; b2[3] = bfhi(w.w) * rs * gb[3];
                orow[c4] = a; orow[c4 + 1] = b2; } }
    }
#undef IN
#undef SEAM
}

extern "C" void kernel_launch(void* const* d_in, const int* in_sizes, int n_in, void* d_out, int out_size, void* d_ws, size_t ws_size, hipStream_t stream) {
    static int grid = 0;
    if (grid == 0) {
        if (n_in != 21 || out_size != MT * DM || ws_size < WS_END) { fprintf(stderr, "kernel_launch: unexpected problem shape (n_in %d, out %d, ws %zu)\n", n_in, out_size, ws_size); grid = -1; return; }
        int dev = 0, cus = 0, per_cu = 0;
        (void)hipGetDevice(&dev); (void)hipDeviceGetAttribute(&cus, hipDeviceAttributeMultiprocessorCount, dev);
        (void)hipFuncSetAttribute((const void*)mk_fwd, hipFuncAttributeMaxDynamicSharedMemorySize, LDS_BYTES);
        if (hipOccupancyMaxActiveBlocksPerMultiprocessor(&per_cu, (const void*)mk_fwd, NWAVES * 64, LDS_BYTES) != hipSuccess || per_cu < 1) per_cu = 1;
        (void)hipGetLastError();
        if (cus <= 0) cus = 256;
        grid = cus * per_cu;
    }
    if (grid < 0) return;
    Args a{};
    for (int i = 0; i < 21; ++i) a.in[i] = (const float*)d_in[i];
    a.out = (float*)d_out; a.ws = (unsigned char*)d_ws;
#if MK_PER_PHASE
    for (int ph = 0; ph < NPHASE; ++ph) { a.ph_lo = ph; a.ph_hi = ph + 1; hipLaunchKernelGGL(mk_fwd, dim3(grid), dim3(NWAVES * 64), LDS_BYTES, stream, a); }
#else
    a.ph_lo = 0; a.ph_hi = NPHASE;
    (void)hipMemsetAsync((unsigned char*)d_ws + WS_BAR, 0, BAR_BYTES, stream);
    void* params[] = {(void*)&a};
    hipError_t e = hipLaunchCooperativeKernel((const void*)mk_fwd, dim3(grid), dim3(NWAVES * 64), params, LDS_BYTES, stream);
    if (e != hipSuccess) fprintf(stderr, "cooperative launch failed: %s (grid %d)\n", hipGetErrorString(e), grid);
#endif
}
```
